# Optimizing an MI355X kernel written in HIP

```python
import math
import jax, jax.numpy as jnp
from jax import lax
import numpy as np

D_MODEL = 2048
BATCH = 8
SEQ = 2048
DEPTH = 1
DEC_BATCH = 2
DEC_SEQ = 16384
PAST_LEN = 128

SSM_EXPAND = 2
D_INNER = SSM_EXPAND * D_MODEL
SSM_HEAD_DIM = 64
SSM_HEADS = D_INNER // SSM_HEAD_DIM
SSM_GROUPS = 8
D_STATE = 128
GN = SSM_GROUPS * D_STATE
CONV_DIM = D_INNER + 2 * GN
CONV_WIDTH = 5
SSD_CHUNK = 128
ATTN_HEAD_DIM = 128
ATTN_HEADS = D_MODEL // ATTN_HEAD_DIM
KV_HEADS = 4
Q_PER_KV = ATTN_HEADS // KV_HEADS
WINDOW = 128
ATTN_BLOCK = 128
ATTN_SCALE = ATTN_HEAD_DIM ** -0.5
REL_BUCKETS = 32
REL_MAX_DIST = 128
D_FF = -(-8 * D_MODEL // (3 * 256)) * 256
EPS = 1e-6
Q_DIM = ATTN_HEADS * ATTN_HEAD_DIM
KV_DIM = KV_HEADS * ATTN_HEAD_DIM
IN_SPLITS = (D_INNER, CONV_DIM, 2 * SSM_HEADS, Q_DIM, KV_DIM, KV_DIM, 2 * D_MODEL)
IN_PROJ_DIM = D_INNER + CONV_DIM + 2 * SSM_HEADS + Q_DIM + 2 * KV_DIM + 2 * D_MODEL

kernel_name = 'hybrid_ssd_swa_encoder'


def rmsnorm(x, w):
    xf = x.astype(jnp.float32)
    y = xf * lax.rsqrt(jnp.mean(xf * xf, axis=-1, keepdims=True) + EPS) * w.astype(jnp.float32)
    return y.astype(x.dtype)


def centred_depthwise_conv(x, w, b):
    S = x.shape[1]
    half = CONV_WIDTH // 2
    xp = jnp.pad(x, ((0, 0), (half, half), (0, 0)))
    out = b
    for j in range(CONV_WIDTH):
        out = out + xp[:, j:j + S] * w[j]
    return out


def ssd_chunked_scan(x, dt, a, bm, cm):
    bsz, S, H, P = x.shape
    nc = S // SSD_CHUNK
    K = H // SSM_GROUPS

    def chunks(t):
        t = t.reshape((bsz, nc, SSD_CHUNK) + t.shape[2:])
        return jnp.moveaxis(t, 1, 0)

    xc = chunks(x.reshape(bsz, S, SSM_GROUPS, K, P))
    dtc = chunks(dt.reshape(bsz, S, SSM_GROUPS, K))
    ac = chunks((dt * a).reshape(bsz, S, SSM_GROUPS, K))
    bc, cc = chunks(bm), chunks(cm)
    lower = jnp.tril(jnp.ones((SSD_CHUNK, SSD_CHUNK), dtype=bool))

    def step(state, inp):
        xk, dtk, ak, bk, ck = inp
        acum = jnp.cumsum(ak, axis=1)
        xdt = xk * dtk[..., None]
        at = jnp.moveaxis(acum, 1, -1)
        seg = at[..., :, None] - at[..., None, :]
        decay = jnp.exp(jnp.where(lower, seg, -jnp.inf))
        cb = jnp.einsum('blgn,bsgn->bgls', ck, bk)
        y = jnp.einsum('bgls,bgkls,bsgkp->blgkp', cb, decay, xdt)
        y = y + jnp.einsum('blgn,bgkpn,blgk->blgkp', ck, state, jnp.exp(acum))
        last = acum[:, -1]
        w_in = jnp.exp(last[:, None] - acum)
        state = state * jnp.exp(last)[..., None, None] + jnp.einsum('bsgn,bsgk,bsgkp->bgkpn', bk, w_in, xdt)
        return state, y

    state0 = jnp.zeros((bsz, SSM_GROUPS, K, P, D_STATE), jnp.float32)
    _, y = lax.scan(step, state0, (xc, dtc, ac, bc, cc))
    return jnp.moveaxis(y, 0, 1).reshape(bsz, S, H, P)


def ssd_mixer(z, xbc, dt_raw, conv_w, conv_b, dt_bias, a_log, d_skip, norm_w, w_branch):
    bsz, S, _ = z.shape
    f32 = jnp.float32
    xbc = jax.nn.silu(centred_depthwise_conv(xbc, conv_w, conv_b)).astype(f32)
    xs = xbc[..., :D_INNER].reshape(bsz, S, SSM_HEADS, SSM_HEAD_DIM)
    bm = xbc[..., D_INNER:D_INNER + GN].reshape(bsz, S, SSM_GROUPS, D_STATE)
    cm = xbc[..., D_INNER + GN:].reshape(bsz, S, SSM_GROUPS, D_STATE)
    dt = jax.nn.softplus(dt_raw.astype(f32).reshape(bsz, S, 2, SSM_HEADS) + dt_bias.astype(f32))
    a = -jnp.exp(a_log.astype(f32))
    flip = lambda t: jnp.flip(t, axis=1)
    y_fwd = ssd_chunked_scan(xs, dt[:, :, 0], a[0], bm, cm)
    y_bwd = flip(ssd_chunked_scan(flip(xs), flip(dt[:, :, 1]), a[1], flip(bm), flip(cm)))
    y = y_fwd + y_bwd + xs * d_skip.astype(f32)[:, None]
    y = y.reshape(bsz, S, D_INNER) * jax.nn.silu(z.astype(f32))
    yg = y.reshape(bsz, S, SSM_GROUPS, D_INNER // SSM_GROUPS)
    yg = yg * lax.rsqrt(jnp.mean(yg * yg, axis=-1, keepdims=True) + EPS)
    y = yg.reshape(bsz, S, D_INNER) * norm_w.astype(f32)
    return y.astype(z.dtype) @ w_branch


def t5_buckets(rel):
    half = REL_BUCKETS // 2
    ret = (rel > 0).astype(np.int32) * half
    n = np.abs(rel)
    max_exact = half // 2
    large = max_exact + (np.log(np.maximum(n, 1) / max_exact) / np.log(REL_MAX_DIST / max_exact)
                         * (half - max_exact)).astype(np.int32)
    large = np.minimum(large, half - 1)
    return ret + np.where(n < max_exact, n, large).astype(np.int32)


def windowed_gqa(q, k, v, rel_bias, sink, w_branch):
    bsz, S, _ = q.shape
    nb = S // ATTN_BLOCK
    blk = ATTN_BLOCK
    q = q.reshape(bsz, nb, blk, KV_HEADS, Q_PER_KV, ATTN_HEAD_DIM)

    def band(t):
        t = t.reshape(bsz, S, KV_HEADS, ATTN_HEAD_DIM)
        t = jnp.pad(t, ((0, 0), (blk, blk), (0, 0), (0, 0))).reshape(bsz, nb + 2, blk, KV_HEADS, ATTN_HEAD_DIM)
        return jnp.concatenate([t[:, :-2], t[:, 1:-1], t[:, 2:]], axis=2)

    kw, vw = band(k), band(v)
    logits = jnp.einsum('bnqhrd,bnkhd->bnhrqk', q, kw).astype(jnp.float32) * ATTN_SCALE
    rel = np.arange(3 * blk)[None, :] - blk - np.arange(blk)[:, None]
    bias = rel_bias.astype(jnp.float32)[t5_buckets(rel)]
    bias = jnp.transpose(bias, (2, 0, 1)).reshape(KV_HEADS, Q_PER_KV, blk, 3 * blk)
    key_pos = (np.arange(nb)[:, None] - 1) * blk + np.arange(3 * blk)[None, :]
    valid = (np.abs(rel) <= WINDOW)[None] & ((key_pos >= 0) & (key_pos < S))[:, None, :]
    logits = jnp.where(valid[None, :, None, None], logits + bias[None, None], -jnp.inf)
    sink_l = sink.astype(jnp.float32).reshape(KV_HEADS, Q_PER_KV)[None, None, :, :, None, None]
    m = jnp.maximum(jnp.max(logits, axis=-1, keepdims=True), sink_l)
    p = jnp.exp(logits - m)
    probs = p / (jnp.sum(p, axis=-1, keepdims=True) + jnp.exp(sink_l - m))
    out = jnp.einsum('bnhrqk,bnkhd->bnqhrd', probs.astype(v.dtype), vw)
    return out.reshape(bsz, S, Q_DIM) @ w_branch


def trunk(x, mix_norm_w, w_in, conv_w, conv_b, dt_bias, a_log, d_skip, ssm_norm_w, w_ssm_branch,
          rel_bias, attn_sink, w_attn_branch, w_out, ffn_norm_w, w_ffn_in, w_ffn_out, final_norm_w):
    bsz, S, _ = x.shape
    h = x
    cuts = list(np.cumsum(IN_SPLITS)[:-1])
    for l in range(DEPTH):
        xn = rmsnorm(h, mix_norm_w[l])
        proj = xn @ w_in[l]
        z, xbc, dt_raw, q, k, v, gate_pre = jnp.split(proj, cuts, axis=-1)
        y_a = ssd_mixer(z, xbc, dt_raw, conv_w[l], conv_b[l], dt_bias[l], a_log[l], d_skip[l],
                        ssm_norm_w[l], w_ssm_branch[l])
        y_b = windowed_gqa(q, k, v, rel_bias, attn_sink[l], w_attn_branch[l])
        g = jax.nn.sigmoid(gate_pre.astype(jnp.float32)).reshape(bsz, S, 2, D_MODEL)
        merged = (g[:, :, 0] * y_a.astype(jnp.float32) + g[:, :, 1] * y_b.astype(jnp.float32)).astype(x.dtype)
        h = h + merged @ w_out[l]
        hn = rmsnorm(h, ffn_norm_w[l])
        gt, up = jnp.split(hn @ w_ffn_in[l], 2, axis=-1)
        h = h + (jax.nn.silu(gt) * up) @ w_ffn_out[l]
    return rmsnorm(h, final_norm_w)


def setup_inputs(seed: int = 0) -> dict:
    key = jax.random.key(seed)
    ks = jax.random.split(key, 20)
    f32 = jnp.float32
    nrm = lambda k, shape, s: jax.random.normal(k, shape, f32) * s
    u = jax.random.uniform(ks[6], (DEPTH, 2, SSM_HEADS), f32)
    dt0 = jnp.exp(u * (math.log(0.1) - math.log(0.001)) + math.log(0.001))
    dt_bias = dt0 + jnp.log(-jnp.expm1(-dt0))
    return {
        'x_prompt': nrm(ks[0], (BATCH, SEQ, D_MODEL), 1.0),
        'x_sample': nrm(ks[1], (DEC_BATCH, DEC_SEQ, D_MODEL), 1.0),
        'mix_norm_w': 1.0 + nrm(ks[2], (DEPTH, D_MODEL), 0.02),
        'w_in': nrm(ks[3], (DEPTH, D_MODEL, IN_PROJ_DIM), D_MODEL ** -0.5),
        'conv_w': nrm(ks[4], (DEPTH, CONV_WIDTH, CONV_DIM), CONV_WIDTH ** -0.5),
        'conv_b': nrm(ks[5], (DEPTH, CONV_DIM), 0.01),
        'dt_bias': dt_bias,
        'a_log': jnp.log(jax.random.uniform(ks[7], (DEPTH, 2, SSM_HEADS), f32, 1.0, 16.0)),
        'd_skip': 1.0 + nrm(ks[8], (DEPTH, SSM_HEADS), 0.02),
        'ssm_norm_w': 1.0 + nrm(ks[9], (DEPTH, D_INNER), 0.02),
        'w_ssm_branch': nrm(ks[10], (DEPTH, D_INNER, D_MODEL), D_INNER ** -0.5),
        'rel_bias': nrm(ks[11], (REL_BUCKETS, ATTN_HEADS), 0.5),
        'attn_sink': nrm(ks[12], (DEPTH, ATTN_HEADS), 0.5),
        'w_attn_branch': nrm(ks[13], (DEPTH, Q_DIM, D_MODEL), Q_DIM ** -0.5),
        'w_out': nrm(ks[14], (DEPTH, D_MODEL, D_MODEL), D_MODEL ** -0.5),
        'ffn_norm_w': 1.0 + nrm(ks[15], (DEPTH, D_MODEL), 0.02),
        'w_ffn_in': nrm(ks[16], (DEPTH, D_MODEL, 2 * D_FF), D_MODEL ** -0.5),
        'w_ffn_out': nrm(ks[17], (DEPTH, D_FF, D_MODEL), D_FF ** -0.5),
        'final_norm_w': 1.0 + nrm(ks[18], (D_MODEL,), 0.02),
    }


def reference(x_prompt, x_sample, mix_norm_w, w_in, conv_w, conv_b, dt_bias, a_log, d_skip, ssm_norm_w,
              w_ssm_branch, rel_bias, attn_sink, w_attn_branch, w_out, ffn_norm_w, w_ffn_in, w_ffn_out,
              final_norm_w):
    y_prompt = trunk(x_prompt, mix_norm_w, w_in, conv_w, conv_b, dt_bias, a_log, d_skip, ssm_norm_w,
                     w_ssm_branch, rel_bias, attn_sink, w_attn_branch, w_out, ffn_norm_w, w_ffn_in,
                     w_ffn_out, final_norm_w)
    y_sample = trunk(x_sample, mix_norm_w, w_in, conv_w, conv_b, dt_bias, a_log, d_skip, ssm_norm_w,
                     w_ssm_branch, rel_bias, attn_sink, w_attn_branch, w_out, ffn_norm_w, w_ffn_in,
                     w_ffn_out, final_norm_w)
    return (y_prompt, y_sample)
```

```cpp
#include <hip/hip_runtime.h>
#include <hip/hip_bf16.h>
#include <hip/hip_cooperative_groups.h>
#include <cstdio>
#include <cmath>
namespace cg = cooperative_groups;

typedef unsigned short u16;
using bf16x8 = __attribute__((ext_vector_type(8))) short;
using s16x4 = __attribute__((ext_vector_type(4))) short;
using f32x4 = __attribute__((ext_vector_type(4))) float;
typedef __bf16 bf2_t __attribute__((ext_vector_type(2)));

constexpr int DM = 2048, DI = 4096, CONVD = 6144, DFF = 5632;
constexpr int PT = 16384;
constexpr int NPASS = 3;
constexpr int NIN = 13568;
constexpr int WIN_LD = 17536;
constexpr float EPS = 1e-6f;
constexpr int NTHR = 512;

constexpr size_t MiB = (size_t)1 << 20;
constexpr size_t OFF_WIN = 0, OFF_WGATE = 53 * MiB, OFF_WSSM = 69 * MiB, OFF_WATTN = 85 * MiB, OFF_WOUT = 93 * MiB,
                 OFF_WFFI = 101 * MiB, OFF_WFFO = 145 * MiB, OFF_RA = 167 * MiB, OFF_RB = 359 * MiB, OFF_XN = 551 * MiB,
                 OFF_Z = 615 * MiB, OFF_Q = 743 * MiB, OFF_K = 807 * MiB, OFF_V = 823 * MiB, OFF_DTR = 839 * MiB,
                 OFF_DTT = 847 * MiB, OFF_CUM = 855 * MiB, OFF_YB = 863 * MiB, OFF_CTL = 991 * MiB, OFF_WW = 992 * MiB, OFF_EE = 1000 * MiB,
                 WS_NEED = 1008 * MiB;
constexpr int LDS_BYTES = 145408;

struct Params {
  const float *x_prompt, *x_sample, *mix_norm_w, *w_in, *conv_w, *conv_b, *dt_bias, *a_log, *d_skip, *ssm_norm_w,
      *w_ssm, *rel_bias, *attn_sink, *w_attn, *w_out, *ffn_norm_w, *w_ffn_in, *w_ffn_out, *final_norm_w;
  float* out;
  unsigned char* ws;
  unsigned char bucket[264];
};

extern __shared__ __attribute__((aligned(16))) unsigned char smem[];

__device__ __forceinline__ int tidx(const int wvi) {
  int l;
  asm volatile("v_mbcnt_lo_u32_b32 %0, -1, 0\n\tv_mbcnt_hi_u32_b32 %0, -1, %0" : "=v"(l));
  return wvi * 64 + l;
}
template <class T>
__device__ __forceinline__ T* lptr(T* p) {
  return p;
}
__device__ __forceinline__ const float* pass_xin(const Params& P, int pass) {
  const float* base = (pass == 0) ? P.x_prompt : P.x_sample;
  const unsigned off = (pass == 0) ? 0u : (unsigned)(pass - 1) * (unsigned)(PT * DM);
  return lptr(base + off);
}
__device__ __forceinline__ float* pass_out(const Params& P, int pass) {
  const unsigned off = (unsigned)pass * (unsigned)(PT * DM);
  return lptr(P.out + off);
}
__device__ __forceinline__ unsigned char* wsp_plain(const Params& P) { return P.ws; }
__device__ __forceinline__ unsigned char* wsp(const Params& P) { return P.ws; }
__device__ __forceinline__ unsigned pk2(float a, float b) {
  bf2_t v; v[0] = (__bf16)a; v[1] = (__bf16)b;
  return __builtin_bit_cast(unsigned, v);
}
__device__ __forceinline__ float bf2f(u16 h) { return __uint_as_float(((unsigned)h) << 16); }
__device__ __forceinline__ float bflo(unsigned u) { return __uint_as_float(u << 16); }
__device__ __forceinline__ float bfhi(unsigned u) { return __uint_as_float(u & 0xffff0000u); }
__device__ __forceinline__ float sigmoidf_(float x) { return __builtin_amdgcn_rcpf(1.f + __expf(-x)); }
__device__ __forceinline__ float siluf_(float x) { return x * __builtin_amdgcn_rcpf(1.f + __expf(-x)); }
__device__ __forceinline__ float shfl_src(float v, int src) {
  return __int_as_float(__builtin_amdgcn_ds_bpermute(src << 2, __float_as_int(v)));
}
__device__ __forceinline__ float4 ldnt4(const float* p) {
  typedef float f4v __attribute__((ext_vector_type(4)));
  const f4v v = __builtin_nontemporal_load((const f4v*)p);
  return make_float4(v[0], v[1], v[2], v[3]);
}
__device__ __forceinline__ uint4 ldnt4u(const u16* p) {
  typedef unsigned u4v __attribute__((ext_vector_type(4)));
  const u4v v = __builtin_nontemporal_load((const u4v*)p);
  return make_uint4(v[0], v[1], v[2], v[3]);
}
__device__ __forceinline__ float wave_sum(float v, int lane) {
#pragma unroll
  for (int o = 32; o > 0; o >>= 1) v += shfl_src(v, lane ^ o);
  return v;
}
__device__ __forceinline__ s16x4 ldtr(const u16* p) {
  return __builtin_amdgcn_ds_read_tr16_b64_v4i16((__attribute__((address_space(3))) s16x4*)p);
}
__device__ __forceinline__ bf16x8 cat8(s16x4 a, s16x4 b) {
  bf16x8 r; r[0] = a[0]; r[1] = a[1]; r[2] = a[2]; r[3] = a[3]; r[4] = b[0]; r[5] = b[1]; r[6] = b[2]; r[7] = b[3];
  return r;
}
__device__ __forceinline__ bf16x8 pack8(float a0, float a1, float a2, float a3, float a4, float a5, float a6, float a7) {
  uint4 u; u.x = pk2(a0, a1); u.y = pk2(a2, a3); u.z = pk2(a4, a5); u.w = pk2(a6, a7);
  return __builtin_bit_cast(bf16x8, u);
}


#define XB_TMO      128
#define XB_XCNT(j)  (256  + 64 * (j))
#define XB_XSUB(j)  (1280 + 64 * (j))
#define XB_XGEN(j)  (2304 + 64 * (j))
#define XB_TOP      3328
#define XB_TOPGEN   3392
#define XCD_BAR_WORDS 3456
#define XB_SPIN_CAP (1u << 22)
#define LAS __attribute__((address_space(3)))
__device__ __forceinline__ unsigned xb_ld(unsigned* p) { return __hip_atomic_load(p, __ATOMIC_RELAXED, __HIP_MEMORY_SCOPE_AGENT); }
__device__ __forceinline__ unsigned xb_add(unsigned* p, unsigned v) { return __hip_atomic_fetch_add(p, v, __ATOMIC_RELAXED, __HIP_MEMORY_SCOPE_AGENT); }
__device__ __forceinline__ unsigned xb_xcc_id() { return (unsigned)__builtin_amdgcn_s_getreg((3 << 11) | 20) & 0xFu; }
#define XB_SPIN(cond, bar) do { unsigned _sp = 0; while (cond) { __builtin_amdgcn_s_sleep(1); \
    if ((++_sp & 255u) == 0u) { if (xb_ld(&(bar)[XB_TMO])) break; if (_sp > XB_SPIN_CAP) { atomicAdd(&(bar)[XB_TMO], 1u); break; } } } } while (0)
struct XcdBarrier { unsigned* bar; unsigned x; volatile LAS unsigned* st; };
__device__ __forceinline__ XcdBarrier xcd_barrier_post(unsigned* bar, volatile LAS unsigned* st, const int wvi) {
  XcdBarrier b; b.bar = bar; b.x = xb_xcc_id(); b.st = st;
  if (tidx(wvi) == 0) (void)xb_add(&bar[XB_XCNT(b.x)], 1u);
  return b;
}
__device__ __forceinline__ void xcd_barrier_complete(unsigned* bar, unsigned x, unsigned& nloc, unsigned& nx) {
  const unsigned G = gridDim.x * gridDim.y * gridDim.z;
  unsigned sum, cnt, mine, sp = 0u;
  for (;;) {
    sum = 0u; cnt = 0u; mine = 0u;
#pragma unroll
    for (unsigned j = 0; j < 16; ++j) { const unsigned c = xb_ld(&bar[XB_XCNT(j)]); sum += c; cnt += (c > 0u) ? 1u : 0u; mine = (j == x) ? c : mine; }
    if (sum == G) break;
    __builtin_amdgcn_s_sleep(1);
    if ((++sp & 255u) == 0u) { if (xb_ld(&bar[XB_TMO])) break; if (sp > XB_SPIN_CAP) { atomicAdd(&bar[XB_TMO], 1u); break; } }
  }
  nloc = mine > 0u ? mine : 1u; nx = cnt > 0u ? cnt : 1u;
}
__device__ __forceinline__ void xcd_barrier(const Params& P, volatile LAS unsigned* st, const int wvi) {
  XcdBarrier b; b.bar = (unsigned*)(wsp_plain(P) + OFF_CTL + 65536); b.x = xb_xcc_id(); b.st = st;
  asm volatile("s_waitcnt vmcnt(0)" ::: "memory");
  __syncthreads();
  if (tidx(wvi) == 0) {
    unsigned* bar = b.bar;
    __builtin_amdgcn_s_waitcnt(0);
    unsigned nloc = b.st[0], nx = b.st[1];
    if (nloc == 0u) { xcd_barrier_complete(bar, b.x, nloc, nx); b.st[0] = nloc; b.st[1] = nx; }
    const unsigned old = xb_add(&bar[XB_XSUB(b.x)], 1u);
    const unsigned gen = old / nloc;
    if (old + 1u == (gen + 1u) * nloc) {
      __builtin_amdgcn_fence(__ATOMIC_RELEASE, "agent");
      asm volatile("s_waitcnt vmcnt(0)" ::: "memory");
      const unsigned og = xb_add(&bar[XB_TOP], 1u);
      const unsigned tg = og / nx;
      if (og + 1u == (tg + 1u) * nx) xb_add(&bar[XB_TOPGEN], 1u);
      else XB_SPIN(xb_ld(&bar[XB_TOPGEN]) == tg, bar);
      __builtin_amdgcn_fence(__ATOMIC_ACQUIRE, "agent");
      xb_add(&bar[XB_XGEN(b.x)], 1u);
      asm volatile("s_waitcnt vmcnt(0)" ::: "memory");
    } else {
      XB_SPIN(xb_ld(&bar[XB_XGEN(b.x)]) == gen, bar);
      __builtin_amdgcn_fence(__ATOMIC_ACQUIRE, "agent");
      asm volatile("s_waitcnt vmcnt(0)" ::: "memory");
    }
  }
  __syncthreads();
}

__device__ __forceinline__ void wconv(const float* __restrict__ src, int ld, int col0, u16* __restrict__ dst, int drow0, int ncols, int K, int mode, const int wvi) {
  float* tile = (float*)smem;
  const int tid = tidx(wvi);
  const int nkt = K >> 6, nnt = ncols >> 6;
  for (int t = blockIdx.x; t < nkt * nnt; t += gridDim.x) {
    const int kt = t % nkt, nt = t / nkt;
    const int k0 = kt << 6, r0 = nt << 6;
    int sc0;
    if (mode == 0) sc0 = col0 + r0;
    else { int t256 = r0 >> 8, wi = r0 & 255; sc0 = (wi < 128) ? (t256 * 128 + wi) : (DFF + t256 * 128 + wi - 128); }
    __syncthreads();
#pragma unroll
    for (int i = 0; i < 2; ++i) {
      int kk = (tid >> 4) + 32 * i, nn = (tid & 15) * 4;
      float4 v = ldnt4(src + (size_t)(k0 + kk) * ld + sc0 + nn);
      tile[kk * 65 + nn] = v.x; tile[kk * 65 + nn + 1] = v.y; tile[kk * 65 + nn + 2] = v.z; tile[kk * 65 + nn + 3] = v.w;
    }
    __syncthreads();
    {
      int nn = tid >> 3, kq = (tid & 7) * 8;
      float f[8];
#pragma unroll
      for (int e = 0; e < 8; ++e) f[e] = tile[(kq + e) * 65 + nn];
      uint4 o; o.x = pk2(f[0], f[1]); o.y = pk2(f[2], f[3]); o.z = pk2(f[4], f[5]); o.w = pk2(f[6], f[7]);
      *(uint4*)(dst + (size_t)(drow0 + r0 + nn) * K + k0 + kq) = o;
    }
  }
  __syncthreads();
}

__device__ __forceinline__ void phase0(const Params& P, const int wvi) {
  unsigned char* ws = wsp(P);
  const int tid0 = tidx(wvi);
  u16* win = (u16*)(ws + OFF_WIN);
  wconv(P.w_in, WIN_LD, 0, win, 0, 4096, DM, 0, wvi);
  wconv(P.w_in, WIN_LD, 4096, win, 4096, 6144, DM, 0, wvi);
  wconv(P.w_in, WIN_LD, 10368, win, 10240, 2048, DM, 0, wvi);
  wconv(P.w_in, WIN_LD, 12416, win, 12288, 512, DM, 0, wvi);
  wconv(P.w_in, WIN_LD, 12928, win, 12800, 512, DM, 0, wvi);
  wconv(P.w_in, WIN_LD, 10240, win, 13312, 128, DM, 0, wvi);
  {
    uint4 z4 = make_uint4(0, 0, 0, 0);
    uint4* pz = (uint4*)(win + (size_t)13440 * DM);
    for (int i = blockIdx.x * NTHR + tid0; i < 128 * DM / 8; i += gridDim.x * NTHR) pz[i] = z4;
  }
  wconv(P.w_in, WIN_LD, 13440, (u16*)(ws + OFF_WGATE), 0, 4096, DM, 0, wvi);
  wconv(P.w_ssm, DM, 0, (u16*)(ws + OFF_WSSM), 0, DM, DI, 0, wvi);
  wconv(P.w_attn, DM, 0, (u16*)(ws + OFF_WATTN), 0, DM, DM, 0, wvi);
  wconv(P.w_out, DM, 0, (u16*)(ws + OFF_WOUT), 0, DM, DM, 0, wvi);
  wconv(P.w_ffn_in, 2 * DFF, 0, (u16*)(ws + OFF_WFFI), 0, 2 * DFF, DM, 1, wvi);
  wconv(P.w_ffn_out, DM, 0, (u16*)(ws + OFF_WFFO), 0, DM, DFF, 0, wvi);
  if (blockIdx.x == 0 && tid0 < 32) {
    int* ctr = (int*)(ws + OFF_CTL);
    __hip_atomic_store(&ctr[tid0], 0, __ATOMIC_RELAXED, __HIP_MEMORY_SCOPE_AGENT);
  }
}

template <bool OUTF32>
__device__ __forceinline__ void rmsnorm_rows(const float* src, const float* w, u16* dstb, float* dstf, const int wvi) {
  const int tid = tidx(wvi);
  const int lane = tid & 63, wv = __builtin_amdgcn_readfirstlane(tid >> 6);
  src = lptr(src); w = lptr(w); dstb = lptr(dstb); dstf = lptr(dstf);
  float4 gw[8];
#pragma unroll
  for (int i = 0; i < 8; ++i) gw[i] = *(const float4*)(w + i * 256 + lane * 4);
  for (int row = blockIdx.x * 8 + wv; row < PT; row += gridDim.x * 8) {
    const float* s = src + (size_t)row * DM;
    float4 v[8];
    float ss = 0.f;
#pragma unroll
    for (int i = 0; i < 8; ++i) {
      v[i] = ldnt4(s + i * 256 + lane * 4);
      ss += v[i].x * v[i].x + v[i].y * v[i].y + v[i].z * v[i].z + v[i].w * v[i].w;
    }
    ss = wave_sum(ss, lane);
    const float rstd = rsqrtf(ss * (1.f / DM) + EPS);
#pragma unroll
    for (int i = 0; i < 8; ++i) {
      const int c = i * 256 + lane * 4;
      const float4 g = gw[i];
      float o0 = v[i].x * rstd * g.x, o1 = v[i].y * rstd * g.y, o2 = v[i].z * rstd * g.z, o3 = v[i].w * rstd * g.w;
      if (OUTF32) {
        *(float4*)(dstf + (size_t)row * DM + c) = make_float4(o0, o1, o2, o3);
      } else {
        uint2 o; o.x = pk2(o0, o1); o.y = pk2(o2, o3);
        *(uint2*)(dstb + (size_t)row * DM + c) = o;
      }
    }
  }
}

template <bool OUTF32>
__device__ __forceinline__ void rmsnorm_rows_bf16(const u16* src, const float* w, u16* dst, float* dstf, const int wvi) {
  const int tid = tidx(wvi);
  const int lane = tid & 63, wv = __builtin_amdgcn_readfirstlane(tid >> 6);
  float4 gw0[4], gw1[4];
#pragma unroll
  for (int i = 0; i < 4; ++i) { gw0[i] = *(const float4*)(w + i * 512 + lane * 8); gw1[i] = *(const float4*)(w + i * 512 + lane * 8 + 4); }
  for (int row = blockIdx.x * 8 + wv; row < PT; row += gridDim.x * 8) {
    uint4 r[4];
    float ss = 0.f;
#pragma unroll
    for (int i = 0; i < 4; ++i) {
      r[i] = OUTF32 ? ldnt4u(src + (size_t)row * DM + i * 512 + lane * 8) : *(const uint4*)(src + (size_t)row * DM + i * 512 + lane * 8);
      const float f0 = bflo(r[i].x), f1 = bfhi(r[i].x), f2 = bflo(r[i].y), f3 = bfhi(r[i].y);
      const float f4 = bflo(r[i].z), f5 = bfhi(r[i].z), f6 = bflo(r[i].w), f7 = bfhi(r[i].w);
      ss += f0 * f0 + f1 * f1 + f2 * f2 + f3 * f3 + f4 * f4 + f5 * f5 + f6 * f6 + f7 * f7;
    }
    ss = wave_sum(ss, lane);
    const float rstd = rsqrtf(ss * (1.f / DM) + EPS);
#pragma unroll
    for (int i = 0; i < 4; ++i) {
      const int c = i * 512 + lane * 8;
      const float4 g0 = gw0[i], g1 = gw1[i];
      if (OUTF32) {
        float* po = dstf + (size_t)row * DM + c;
        *(float4*)po = make_float4(bflo(r[i].x) * rstd * g0.x, bfhi(r[i].x) * rstd * g0.y, bflo(r[i].y) * rstd * g0.z, bfhi(r[i].y) * rstd * g0.w);
        *(float4*)(po + 4) = make_float4(bflo(r[i].z) * rstd * g1.x, bfhi(r[i].z) * rstd * g1.y, bflo(r[i].w) * rstd * g1.z, bfhi(r[i].w) * rstd * g1.w);
      } else {
      uint4 o;
      o.x = pk2(bflo(r[i].x) * rstd * g0.x, bfhi(r[i].x) * rstd * g0.y);
      o.y = pk2(bflo(r[i].y) * rstd * g0.z, bfhi(r[i].y) * rstd * g0.w);
      o.z = pk2(bflo(r[i].z) * rstd * g1.x, bfhi(r[i].z) * rstd * g1.y);
      o.w = pk2(bflo(r[i].w) * rstd * g1.z, bfhi(r[i].w) * rstd * g1.w);
      *(uint4*)(dst + (size_t)row * DM + c) = o;
      }
    }
  }
}

__device__ __forceinline__ uint4 swap_pair(const uint2 a, const uint2 b) {
  const auto rx = __builtin_amdgcn_permlane16_swap(a.x, b.x, false, false);
  const auto ry = __builtin_amdgcn_permlane16_swap(a.y, b.y, false, false);
  return make_uint4(rx[0], ry[0], rx[1], ry[1]);
}

constexpr int BK = 64, HALF = 128, HT = HALF * BK;
__device__ __forceinline__ int lds_byte(int r, int c) {
  int st = (r >> 4) * 2 + (c >> 5), rr = r & 15, cc = c & 31, ob = rr * 64 + cc * 2;
  return st * 1024 + (ob ^ (((ob >> 9) & 1) << 5));
}
__device__ __forceinline__ void stage_rc(int b, int& R, int& C) {
  int st = b / 1024, sb = b % 1024, swz = sb ^ (((sb >> 9) & 1) << 5);
  R = (st >> 1) * 16 + swz / 64; C = (st & 1) * 32 + (swz % 64) / 2;
}

template <int PRE>
__device__ __forceinline__ void gemm_kloop(const u16* __restrict__ A, const u16* __restrict__ Bt, const int K, const int brow,
                                           const int bcol, const int brow_n, const int bcol_n, f32x4 (&acc)[2][2][4][2], const int tid,
                                           const int wvi) {
  u16* shm = (u16*)smem;
#define SA(b, h) (shm + ((b) * 2 + (h)) * HT)
#define SB(b, h) (shm + (4 + (b) * 2 + (h)) * HT)
#define STAGE(P_, BASE, br, kt) do { const u16* _gb = (BASE) + (long)(br) * K + (long)(kt) * BK; \
    _Pragma("unroll") for (int _i = 0; _i < 2; ++_i) { \
      __builtin_amdgcn_global_load_lds((const unsigned*)(_gb + (long)_i * 64 * K + lane_off), \
        (unsigned*)((char*)(P_) + lds_wbase + _i * 8192), 16, 0, 0); } } while (0)
#define LDA(dst, b, h) _Pragma("unroll") for (int m = 0; m < 4; ++m) _Pragma("unroll") for (int k = 0; k < 2; ++k) \
    dst[m][k] = *reinterpret_cast<const bf16x8*>((char*)SA(b, h) + lds_byte(wr * 64 + m * 16 + fr, k * 32 + fq * 8))
#define LDB(dst, b, h) _Pragma("unroll") for (int n = 0; n < 2; ++n) _Pragma("unroll") for (int k = 0; k < 2; ++k) \
    dst[n][k] = *reinterpret_cast<const bf16x8*>((char*)SB(b, h) + lds_byte(wc * 32 + n * 16 + fr, k * 32 + fq * 8))
#define MMA(ai, bj, At_, Bt_) do { __builtin_amdgcn_s_setprio(1); \
    _Pragma("unroll") for (int m = 0; m < 4; ++m) _Pragma("unroll") for (int n = 0; n < 2; ++n) _Pragma("unroll") for (int k = 0; k < 2; ++k) \
      acc[ai][bj][m][n] = __builtin_amdgcn_mfma_f32_16x16x32_bf16(At_[m][k], Bt_[n][k], acc[ai][bj][m][n], 0, 0, 0); \
    __builtin_amdgcn_s_setprio(0); } while (0)
#define WAIT_V(n) asm volatile("s_waitcnt vmcnt(" #n ")" ::: "memory")
#define WAIT_L(n) asm volatile("s_waitcnt lgkmcnt(" #n ")" ::: "memory")
#define BAR __builtin_amdgcn_s_barrier()
#define SCHED __builtin_amdgcn_sched_barrier(0)
  const int wid = wvi, lane = tid & 63, wr = wid >> 2, wc = wid & 3, fr = lane & 15, fq = lane >> 4;
  bf16x8 At[4][2], B0[2][2], B1[2][2];
  const int nt = K / BK;
  const unsigned lds_wbase = wid * 1024;
  unsigned lane_off;
  { int _r, _c; stage_rc(tid * 16, _r, _c); lane_off = (unsigned)(_r * K + _c); }
#define STAGEW(P_, BASE, cur, nxt, kt_) do { const bool _wr = (kt_) >= nt; \
    STAGE(P_, BASE, (_wr ? (nxt) : (cur)), (_wr ? (kt_) - nt : (kt_))); } while (0)
  if (PRE == 2) {
    STAGE(SB(0, 0), Bt, bcol, 0); STAGE(SA(0, 0), A, brow, 0);
    STAGE(SB(0, 1), Bt, bcol + HALF, 0); STAGE(SA(0, 1), A, brow + HALF, 0);
    if (wr == 1) BAR;
    WAIT_V(4); BAR;
    STAGE(SB(1, 0), Bt, bcol, 1); STAGE(SA(1, 0), A, brow, 1); STAGE(SB(1, 1), Bt, bcol + HALF, 1);
    WAIT_V(6); BAR;
    return;
  }
  for (int t = 0; t < nt; t += 2) {
    LDB(B0, 0, 0); SCHED; LDA(At, 0, 0); STAGE(SA(1, 1), A, brow + HALF, t + 1);
    WAIT_L(8); BAR; WAIT_L(0); MMA(0, 0, At, B0); BAR; SCHED;
    LDB(B1, 0, 1); STAGEW(SB(0, 0), Bt, bcol, bcol_n, t + 2);
    BAR; WAIT_L(0); MMA(0, 1, At, B1); BAR;
    LDA(At, 0, 1); STAGEW(SA(0, 0), A, brow, brow_n, t + 2);
    BAR; WAIT_L(0); MMA(1, 0, At, B0); BAR; SCHED;
    STAGEW(SB(0, 1), Bt, bcol + HALF, bcol_n + HALF, t + 2);
    WAIT_V(6); BAR; MMA(1, 1, At, B1); BAR;
    LDB(B0, 1, 0); SCHED; LDA(At, 1, 0); STAGEW(SA(0, 1), A, brow + HALF, brow_n + HALF, t + 2);
    WAIT_L(8); BAR; WAIT_L(0); MMA(0, 0, At, B0); BAR; SCHED;
    LDB(B1, 1, 1); STAGEW(SB(1, 0), Bt, bcol, bcol_n, t + 3);
    BAR; WAIT_L(0); MMA(0, 1, At, B1); BAR;
    LDA(At, 1, 1); STAGEW(SA(1, 0), A, brow, brow_n, t + 3);
    BAR; WAIT_L(0); MMA(1, 0, At, B0); BAR; SCHED;
    STAGEW(SB(1, 1), Bt, bcol + HALF, bcol_n + HALF, t + 3);
    WAIT_V(6); BAR; MMA(1, 1, At, B1); BAR;
  }
  if (wr == 0) BAR;
#undef STAGEW
#undef SA
#undef SB
#undef STAGE
#undef LDA
#undef LDB
#undef MMA
}

template <int MODE>
__device__ __forceinline__ void gemm_phase(const Params& P, const int pass, const int wvi, const int vb, const int u_stride_in = 0, const int u_end_in = 0,
                                           const int tn_skip = -1) {
  unsigned char* ws = wsp(P);
  const int tid = tidx(wvi);
  const u16 *W, *Act;
  int K, nN;
  if (MODE == 0) { W = (const u16*)(ws + OFF_WIN); Act = (const u16*)(ws + OFF_XN); K = DM; nN = NIN / 256; }
  else if (MODE == 1) { W = (const u16*)(ws + OFF_WGATE); Act = (const u16*)(ws + OFF_XN); K = DM; nN = 16; }
  else if (MODE == 2) { W = (const u16*)(ws + OFF_WSSM); Act = (const u16*)(ws + OFF_RA); K = DI; nN = 8; }
  else if (MODE == 6) { W = (const u16*)(ws + OFF_WATTN); Act = (const u16*)(ws + OFF_Q); K = DM; nN = 8; }
  else if (MODE == 3) { W = (const u16*)(ws + OFF_WOUT); Act = (const u16*)(ws + OFF_RB + 128 * MiB); K = DM; nN = 8; }
  else if (MODE == 4) { W = (const u16*)(ws + OFF_WFFI); Act = (const u16*)(ws + OFF_RB + 64 * MiB); K = DM; nN = 44; }
  else { W = (const u16*)(ws + OFF_WFFO); Act = (const u16*)(ws + OFF_RA); K = DFF; nN = 8; }
  const float* xin = pass_xin(P, pass);
  float* outp = pass_out(P, pass);
  const int nM = PT / 256;
  const int wid = wvi, lane = tid & 63, wr = wid >> 2, wc = wid & 3;
  const int nunits = u_end_in ? u_end_in : (tn_skip >= 0 ? (nN - 1) * nM : nN * nM);
  const int ustride = u_stride_in ? u_stride_in : (int)gridDim.x;
  if (vb < nunits) {
    f32x4 acc[2][2][4][2];
    gemm_kloop<2>(W, Act, K, (vb / nM + ((tn_skip >= 0 && vb / nM >= tn_skip) ? 1 : 0)) * 256, (vb % nM) * 256, 0, 0, acc, tid, wvi);
  for (int u = vb; u < nunits; u += ustride) {
    const int tm = u % nM, tn = u / nM + ((tn_skip >= 0 && u / nM >= tn_skip) ? 1 : 0);
    const int brow = tn * 256, bcol = tm * 256;
    const int un = u + ustride;
    const bool has_next = un < nunits;
    const int tn_n = un / nM + ((tn_skip >= 0 && un / nM >= tn_skip) ? 1 : 0);
    const int brow_n = has_next ? tn_n * 256 : brow, bcol_n = has_next ? (un % nM) * 256 : bcol;
#pragma unroll
    for (int a = 0; a < 2; ++a)
#pragma unroll
      for (int b = 0; b < 2; ++b)
#pragma unroll
        for (int m = 0; m < 4; ++m)
#pragma unroll
          for (int n = 0; n < 2; ++n) acc[a][b][m][n] = f32x4{0.f, 0.f, 0.f, 0.f};
    gemm_kloop<3>(W, Act, K, brow, bcol, brow_n, bcol_n, acc, tid, wvi);
#pragma unroll
    for (int a = 0; a < 2; ++a)
#pragma unroll
      for (int b = 0; b < 2; ++b)
#pragma unroll
        for (int m = 0; m < 4; ++m)
#pragma unroll
          for (int n = 0; n < 2; ++n) asm volatile("" : "+v"(acc[a][b][m][n]));
    int lane_e = lane;
    asm volatile("" : "+v"(lane_e));
    const int fr = lane_e & 15, fq = lane_e >> 4;
    if (MODE == 4) {
      u16* act = (u16*)(ws + OFF_RA);
      uint2 opend4[2];
#pragma unroll
      for (int bj = 0; bj < 2; ++bj)
#pragma unroll
        for (int m = 0; m < 4; ++m)
#pragma unroll
          for (int n = 0; n < 2; ++n) {
            int lane_i = lane_e;
            asm volatile("" : "+v"(lane_i));
            const int fr = lane_i & 15, fq = lane_i >> 4;
            const int nc = tn * 128 + wr * 64 + m * 16 + fq * 4;
            const int tok = bcol + bj * 128 + wc * 32 + n * 16 + fr;
            f32x4 g = acc[0][bj][m][n], up = acc[1][bj][m][n];
            uint2 o;
            o.x = pk2(siluf_(g[0]) * up[0], siluf_(g[1]) * up[1]);
            o.y = pk2(siluf_(g[2]) * up[2], siluf_(g[3]) * up[3]);
            if ((m & 1) == 0) opend4[n] = o;
            else {
              const int ncw = tn * 128 + wr * 64 + ((m & ~1) + (fq & 1)) * 16 + (fq & ~1) * 4;
              *(uint4*)(act + (size_t)tok * DFF + ncw) = swap_pair(opend4[n], o);
            }
          }
    } else {
      uint2 opend[2];
#pragma unroll
      for (int ai = 0; ai < 2; ++ai)
#pragma unroll
        for (int bj = 0; bj < 2; ++bj)
#pragma unroll
          for (int m = 0; m < 4; ++m)
#pragma unroll
            for (int n = 0; n < 2; ++n) {
              const int nc = brow + ai * 128 + wr * 64 + m * 16 + fq * 4;
              const int tok = bcol + bj * 128 + wc * 32 + n * 16 + fr;
              const int ncw = brow + ai * 128 + wr * 64 + ((m & ~1) + (fq & 1)) * 16 + (fq & ~1) * 4;
#define WIDE_STORE(BASE, LD, COFF, O) do { if ((m & 1) == 0) opend[n] = (O); \
                else *(uint4*)((BASE) + (size_t)tok * (LD) + (ncw - (COFF))) = swap_pair(opend[n], (O)); } while (0)
              f32x4 v = acc[ai][bj][m][n];
              if (MODE == 0) {
                if (tn == 52) {
                  if (ai == 0) *(float4*)((float*)(ws + OFF_DTR) + (size_t)tok * 128 + (nc - 13312)) = make_float4(v[0], v[1], v[2], v[3]);
                } else {
                  u16* dst; int ld, c0;
                  if (tn < 16) { dst = (u16*)(ws + OFF_Z); ld = 4096; c0 = 0; }
                  else if (tn < 40) { dst = (u16*)(ws + OFF_RA); ld = 6144; c0 = 4096; }
                  else if (tn < 48) { dst = (u16*)(ws + OFF_Q); ld = 2048; c0 = 10240; }
                  else if (tn < 50) { dst = (u16*)(ws + OFF_K); ld = 512; c0 = 12288; }
                  else { dst = (u16*)(ws + OFF_V); ld = 512; c0 = 12800; }
                  uint2 o; o.x = pk2(v[0], v[1]); o.y = pk2(v[2], v[3]);
                  WIDE_STORE(dst, ld, c0, o);
                }
              } else if (MODE == 1) {
                uint2 o; o.x = pk2(sigmoidf_(v[0]), sigmoidf_(v[1])); o.y = pk2(sigmoidf_(v[2]), sigmoidf_(v[3]));
                WIDE_STORE((u16*)outp, 4096, 0, o);
              } else if (MODE == 2) {
                const u16* gate = (const u16*)outp;
                uint2 ga = *(const uint2*)(gate + (size_t)tok * 4096 + nc);
                uint2 p1; p1.x = pk2(v[0] * bflo(ga.x), v[1] * bfhi(ga.x)); p1.y = pk2(v[2] * bflo(ga.y), v[3] * bfhi(ga.y));
                *(uint2*)((u16*)(ws + OFF_YB) + (size_t)tok * DM + nc) = p1;
              } else if (MODE == 6) {
                const u16* gate = (const u16*)outp;
                uint2 gb = *(const uint2*)(gate + (size_t)tok * 4096 + 2048 + nc);
                const uint2 p1 = *(const uint2*)((const u16*)(ws + OFF_YB) + (size_t)tok * DM + nc);
                uint2 o;
                o.x = pk2(bflo(p1.x) + v[0] * bflo(gb.x), bfhi(p1.x) + v[1] * bfhi(gb.x));
                o.y = pk2(bflo(p1.y) + v[2] * bflo(gb.y), bfhi(p1.y) + v[3] * bfhi(gb.y));
                WIDE_STORE((u16*)(ws + OFF_RB + 128 * MiB), DM, 0, o);
              } else if (MODE == 3) {
                float4 r = ldnt4(xin + (size_t)tok * DM + nc);
                uint2 hb; hb.x = pk2(r.x + v[0], r.y + v[1]); hb.y = pk2(r.z + v[2], r.w + v[3]);
                WIDE_STORE((u16*)(ws + OFF_RB), DM, 0, hb);
              } else {
                uint2* ph = (uint2*)((u16*)(ws + OFF_RB) + (size_t)tok * DM + nc);
                const uint2 hb = *ph;
                uint2 o; o.x = pk2(bflo(hb.x) + v[0], bfhi(hb.x) + v[1]); o.y = pk2(bflo(hb.y) + v[2], bfhi(hb.y) + v[3]);
                WIDE_STORE((u16*)(ws + OFF_RB), DM, 0, o);
              }
#undef WIDE_STORE
            }
    }
    asm volatile("s_waitcnt vmcnt(0)" ::: "memory");
    if (has_next && wr == 1) __builtin_amdgcn_s_barrier();
  }
  }
}

__device__ __forceinline__ void conv_phase(const Params& P, const int pass, const int wvi) {
  const int S = (pass == 0) ? 2048 : 16384;
  unsigned char* ws = wsp(P);
  const int tid = tidx(wvi);
  const u16* __restrict__ xin = (const u16*)(ws + OFF_RA);
  u16* __restrict__ xo = (u16*)(ws + OFF_RB);
  const float* conv_w = lptr(P.conv_w);
  const float* conv_b = lptr(P.conv_b);
  const float* a_log = lptr(P.a_log);
  const float* dt_bias = lptr(P.dt_bias);
  constexpr int TCH = 16;
  const int nitems = (PT / TCH) * 768;
  for (int idx = blockIdx.x * NTHR + tid; idx < nitems; idx += gridDim.x * NTHR) {
    const int cgp = idx % 768, tch = idx / 768;
    const int c0 = cgp * 8, t0 = tch * TCH;
    const int pos0 = t0 % S;
    float wgt[5][8], bias[8];
#pragma unroll
    for (int j = 0; j < 5; ++j) {
      float4 a = *(const float4*)(conv_w + j * CONVD + c0), b = *(const float4*)(conv_w + j * CONVD + c0 + 4);
      wgt[j][0] = a.x; wgt[j][1] = a.y; wgt[j][2] = a.z; wgt[j][3] = a.w; wgt[j][4] = b.x; wgt[j][5] = b.y; wgt[j][6] = b.z; wgt[j][7] = b.w;
    }
    {
      float4 a = *(const float4*)(conv_b + c0), b = *(const float4*)(conv_b + c0 + 4);
      bias[0] = a.x; bias[1] = a.y; bias[2] = a.z; bias[3] = a.w; bias[4] = b.x; bias[5] = b.y; bias[6] = b.z; bias[7] = b.w;
    }
    const uint4 zz = make_uint4(0, 0, 0, 0);
    uint4 r0 = zz, r1, r2, r3, r4;
    {
      const bool v1 = (pos0 - 2 >= 0), v2 = (pos0 - 1 >= 0);
      const uint4 l1 = ldnt4u(xin + (size_t)(v1 ? t0 - 2 : t0) * CONVD + c0);
      const uint4 l2 = ldnt4u(xin + (size_t)(v2 ? t0 - 1 : t0) * CONVD + c0);
      r1.x = v1 ? l1.x : 0u; r1.y = v1 ? l1.y : 0u; r1.z = v1 ? l1.z : 0u; r1.w = v1 ? l1.w : 0u;
      r2.x = v2 ? l2.x : 0u; r2.y = v2 ? l2.y : 0u; r2.z = v2 ? l2.z : 0u; r2.w = v2 ? l2.w : 0u;
    }
    r3 = ldnt4u(xin + (size_t)(t0) * CONVD + c0);
    r4 = ldnt4u(xin + (size_t)(t0 + 1) * CONVD + c0);
#pragma unroll
    for (int tt = 0; tt < TCH; ++tt) {
      r0 = r1; r1 = r2; r2 = r3; r3 = r4;
      const int pp = pos0 + tt + 2;
      {
        const bool v4 = (pp < S);
        const uint4 l4 = ldnt4u(xin + (size_t)(v4 ? t0 + tt + 2 : t0) * CONVD + c0);
        r4.x = v4 ? l4.x : 0u; r4.y = v4 ? l4.y : 0u; r4.z = v4 ? l4.z : 0u; r4.w = v4 ? l4.w : 0u;
      }
      float o[8];
#pragma unroll
      for (int e = 0; e < 8; ++e) o[e] = bias[e];
#define CONV_ACC(rv, j) do { \
        o[0] += bflo(rv.x) * wgt[j][0]; o[1] += bfhi(rv.x) * wgt[j][1]; \
        o[2] += bflo(rv.y) * wgt[j][2]; o[3] += bfhi(rv.y) * wgt[j][3]; \
        o[4] += bflo(rv.z) * wgt[j][4]; o[5] += bfhi(rv.z) * wgt[j][5]; \
        o[6] += bflo(rv.w) * wgt[j][6]; o[7] += bfhi(rv.w) * wgt[j][7]; } while (0)
      CONV_ACC(r0, 0); CONV_ACC(r1, 1); CONV_ACC(r2, 2); CONV_ACC(r3, 3); CONV_ACC(r4, 4);
#undef CONV_ACC
      uint4 ov;
      ov.x = pk2(siluf_(o[0]), siluf_(o[1])); ov.y = pk2(siluf_(o[2]), siluf_(o[3]));
      ov.z = pk2(siluf_(o[4]), siluf_(o[5])); ov.w = pk2(siluf_(o[6]), siluf_(o[7]));
      *(uint4*)(xo + (size_t)(t0 + tt) * CONVD + c0) = ov;
    }
  }
  const float* dtr = (const float*)(ws + OFF_DTR);
  float* dtt = (float*)(ws + OFF_DTT);
  float* cum = (float*)(ws + OFF_CUM);
  const int lane = tid & 63, wv = __builtin_amdgcn_readfirstlane(tid >> 6);
  for (int it = blockIdx.x * 8 + wv; it < (PT / 128) * 128; it += gridDim.x * 8) {
    const int dh = it & 127, ch = it >> 7, dir = dh >> 6;
    const int tb = ch * 128;
    const float Ac = -__expf(a_log[dh]);
    const float db = dt_bias[dh];
    const int e0 = dir ? (127 - 2 * lane) : (2 * lane), e1 = dir ? (126 - 2 * lane) : (2 * lane + 1);
    float x0 = dtr[(size_t)(tb + e0) * 128 + dh] + db, x1 = dtr[(size_t)(tb + e1) * 128 + dh] + db;
    float d0 = fmaxf(x0, 0.f) + log1pf(__expf(-fabsf(x0))), d1 = fmaxf(x1, 0.f) + log1pf(__expf(-fabsf(x1)));
    float a0 = d0 * Ac, a1 = d1 * Ac;
    float s = a0 + a1;
#pragma unroll
    for (int o = 1; o < 64; o <<= 1) { float v = shfl_src(s, (lane - o) & 63); if (lane >= o) s += v; }
    dtt[(size_t)dh * PT + tb + e0] = d0; dtt[(size_t)dh * PT + tb + e1] = d1;
    cum[(size_t)dh * PT + tb + e0] = s - a1; cum[(size_t)dh * PT + tb + e1] = s;
    const float tot = shfl_src(s, 63), rs = shfl_src(s, (lane >> 4) * 16 + 15);
    float* wwp = (float*)(ws + OFF_WW);
    float* eep = (float*)(ws + OFF_EE);
    wwp[(size_t)dh * PT + tb + e0] = __expf(tot - (s - a1)) * d0; wwp[(size_t)dh * PT + tb + e1] = __expf(tot - s) * d1;
    eep[(size_t)dh * PT + tb + e0] = __expf(rs - (s - a1)) * d0; eep[(size_t)dh * PT + tb + e1] = __expf(rs - s) * d1;
  }
}

constexpr int LDP = 136, LDX = 72;
constexpr size_t OFF_G = OFF_RA + 128 * MiB;
__device__ __forceinline__ void cb_phase(const Params& P, const int wvi) {
  unsigned char* ws = wsp(P);
  const int tid = tidx(wvi), lane = tid & 63, w = wvi, fr = lane & 15, fq = lane >> 4;
  u16* Cs = (u16*)smem;
  u16* Bs = Cs + 128 * LDP;
  const u16* xc = (const u16*)(ws + OFF_RB);
  u16* G = (u16*)(ws + OFF_G);
  for (int itx = blockIdx.x; itx < (PT / 128) * 8; itx += gridDim.x) {
    const int g = itx & 7, ch = itx >> 3;
    const size_t tb = (size_t)ch * 128;
    __syncthreads();
#pragma unroll
    for (int i = 0; i < 4; ++i) {
      const int q = tid + NTHR * i, row = q >> 4, c16 = q & 15;
      const u16* base = xc + (tb + row) * CONVD;
      *(uint4*)(Cs + row * LDP + c16 * 8) = *(const uint4*)(base + 5120 + g * 128 + c16 * 8);
      *(uint4*)(Bs + row * LDP + c16 * 8) = *(const uint4*)(base + 4096 + g * 128 + c16 * 8);
    }
    __syncthreads();
    bf16x8 cf[4];
#pragma unroll
    for (int kk = 0; kk < 4; ++kk) cf[kk] = *(const bf16x8*)(Cs + (w * 16 + fr) * LDP + kk * 32 + fq * 8);
#pragma unroll
    for (int stile = 0; stile < 8; ++stile) {
      f32x4 ga = f32x4{0.f, 0.f, 0.f, 0.f};
#pragma unroll
      for (int kk = 0; kk < 4; ++kk) {
        bf16x8 bfr = *(const bf16x8*)(Bs + (stile * 16 + fr) * LDP + kk * 32 + fq * 8);
        ga = __builtin_amdgcn_mfma_f32_16x16x32_bf16(bfr, cf[kk], ga, 0, 0, 0);
      }
      uint2 o; o.x = pk2(ga[0], ga[1]); o.y = pk2(ga[2], ga[3]);
      *(uint2*)(G + ((size_t)itx * 128 + w * 16 + fr) * 128 + stile * 16 + fq * 4) = o;
    }
  }
  __syncthreads();
}

__device__ __forceinline__ void ssd_item(const Params& P, const int pass, const int item, const int wvi) {
  unsigned char* ws = wsp_plain(P);
  const int tid = tidx(wvi), lane = tid & 63, w = wvi, fr = lane & 15, fq = lane >> 4;
  const int S = (pass == 0) ? 2048 : 16384, nch = S >> 7;
  const int dir = item & 1, h = (item >> 1) & 63, b = item >> 7, g = h >> 3, dh = dir * 64 + h;
  constexpr int SSD_SET = 128 * LDP * 2 + 128 * LDX * 2 + 64 * LDP * 2 + 4 * 128 * 4;
  const u16* xc = (const u16*)(ws + OFF_RB);
  const u16* G = (const u16*)(ws + OFF_G);
  const float* dtt = (const float*)(ws + ((tid < 128) ? OFF_DTT : (tid < 256) ? OFF_CUM : (tid < 384) ? OFF_WW : OFF_EE)) + (size_t)dh * PT + (tid & 127);
  u16* yout = dir ? (u16*)(ws + OFF_YB) : (u16*)(ws + OFF_RA);
  const int it = (w < 4) ? w : 11 - w;
  const int kk_lo = dir ? (it >> 1) : 0, kk_hi = dir ? 3 : (it >> 1);
  f32x4 st[4];
#pragma unroll
  for (int i = 0; i < 4; ++i) st[i] = f32x4{0.f, 0.f, 0.f, 0.f};

  uint4 rb0, rb1, rb2, rb3, rx0, rx1, rc0, rc1, rc2, rc3, rg0, rg1, rg2, rg3;
  float rdt = 0.f;
  const uint4 z4 = make_uint4(0u, 0u, 0u, 0u);
  rg0 = z4; rg1 = z4; rg2 = z4; rg3 = z4;
#define SSD_LDB(i, RB) do { const int q = tid + NTHR * (i), row = q >> 4, c16 = q & 15; \
      RB = *(const uint4*)(xc + (tb_ + row) * CONVD + 4096 + g * 128 + c16 * 8); } while (0)
#define SSD_LDX(i, RX) do { const int q = tid + NTHR * (i), row = q >> 3, c8 = q & 7; \
      RX = *(const uint4*)(xc + (tb_ + row) * CONVD + h * 64 + c8 * 8); } while (0)
#define SSD_LDC(kk, RC) RC = *(const uint4*)(xc + (tb_ + it * 16 + fr) * CONVD + 5120 + g * 128 + (kk) * 32 + fq * 8)
#define SSD_LDG(kk, RG) do { if ((kk) >= kk_lo && (kk) <= kk_hi) \
      RG = *(const uint4*)(G + (((tb_ >> 7) * 8 + g) * 128 + it * 16 + fr) * 128 + (kk) * 32 + fq * 8); } while (0)
#define SSD_ISSUE(c_) do { \
    const int ch_ = dir ? (nch - 1 - (c_)) : (c_); \
    const size_t tb_ = (size_t)b * S + (size_t)ch_ * 128; \
    SSD_LDB(0, rb0); SSD_LDB(1, rb1); SSD_LDB(2, rb2); SSD_LDB(3, rb3); \
    SSD_LDX(0, rx0); SSD_LDX(1, rx1); \
    SSD_LDC(0, rc0); SSD_LDC(1, rc1); SSD_LDC(2, rc2); SSD_LDC(3, rc3); \
    SSD_LDG(0, rg0); SSD_LDG(1, rg1); SSD_LDG(2, rg2); SSD_LDG(3, rg3); \
    rdt = dtt[tb_]; \
  } while (0)
#define SSD_STB(i, RB) do { const int q = tid + NTHR * (i), row = q >> 4, c16 = q & 15; \
      *(uint4*)(Bs + row * LDP + c16 * 8) = RB; } while (0)
#define SSD_STX(i, RX) do { const int q = tid + NTHR * (i), row = q >> 3, c8 = q & 7; \
      *(uint4*)(Xs + row * LDX + c8 * 8) = RX; } while (0)
  unsigned yp[4][2];
#pragma unroll
  for (int pt = 0; pt < 4; ++pt) { yp[pt][0] = 0u; yp[pt][1] = 0u; }
  if (w >= 4) __builtin_amdgcn_s_setprio(1);
  SSD_ISSUE(0);
  for (int c = 0; c < nch; ++c) {
    u16* Bs = (u16*)(smem + (c & 1) * SSD_SET);
    u16* Xs = Bs + 128 * LDP;
    u16* Sb = Xs + 128 * LDX;
    float* fdt = (float*)(Sb + 64 * LDP);
    float* fcum = fdt + 128;
    float* fww = fcum + 128;
    float* fee = fww + 128;
#pragma unroll
    for (int pt = 0; pt < 4; ++pt) {
      uint2 o; o.x = pk2(st[pt][0], st[pt][1]); o.y = pk2(st[pt][2], st[pt][3]);
      *(uint2*)(Sb + (pt * 16 + fr) * LDP + w * 16 + fq * 4) = o;
    }
    SSD_STB(0, rb0); SSD_STB(1, rb1); SSD_STB(2, rb2); SSD_STB(3, rb3);
    SSD_STX(0, rx0); SSD_STX(1, rx1);
    fdt[tid] = rdt;
    const bf16x8 cf0 = __builtin_bit_cast(bf16x8, rc0), cf1 = __builtin_bit_cast(bf16x8, rc1),
                 cf2 = __builtin_bit_cast(bf16x8, rc2), cf3 = __builtin_bit_cast(bf16x8, rc3);
    const uint4 gq0 = rg0, gq1 = rg1, gq2 = rg2, gq3 = rg3;
    __syncthreads();
    if (c > 0) {
      const int chp = dir ? (nch - c) : (c - 1);
      const size_t tbp = (size_t)b * S + (size_t)chp * 128;
#pragma unroll
      for (int pt = 0; pt < 4; pt += 2) {
        const uint2 ya = make_uint2(yp[pt][0], yp[pt][1]), yb2 = make_uint2(yp[pt + 1][0], yp[pt + 1][1]);
        *(uint4*)(yout + (tbp + it * 16 + fr) * DI + h * 64 + (pt + (fq & 1)) * 16 + (fq & ~1) * 4) = swap_pair(ya, yb2);
      }
    }
    SSD_ISSUE((c + 1 < nch) ? (c + 1) : c);
    const float tot = dir ? fcum[0] : fcum[127];
    const float cum_i = fcum[it * 16 + fr];
    const int ii = it * 16 + fr;
    f32x4 y1[4], y2[4];
#pragma unroll
    for (int i = 0; i < 4; ++i) { y1[i] = f32x4{0.f, 0.f, 0.f, 0.f}; y2[i] = f32x4{0.f, 0.f, 0.f, 0.f}; }
    {
      const float dec = __expf(tot);
#pragma unroll
      for (int pt = 0; pt < 4; ++pt)
#pragma unroll
        for (int j = 0; j < 4; ++j) st[pt][j] *= dec;
    }
#pragma unroll
    for (int kk = 0; kk < 4; ++kk) {
      const int s0 = kk * 32 + fq * 8;
      bf16x8 xf[4];
#pragma unroll
      for (int pt = 0; pt < 4; ++pt) {
        const u16* xa = Xs + (kk * 32 + fq * 8 + (fr >> 2)) * LDX + pt * 16 + (fr & 3) * 4;
        xf[pt] = cat8(ldtr(xa), ldtr(xa + 4 * LDX));
      }
      {
        const u16* ba = Bs + (kk * 32 + fq * 8 + (fr >> 2)) * LDP + w * 16 + (fr & 3) * 4;
        const s16x4 b0 = ldtr(ba), b1 = ldtr(ba + 4 * LDP);
        const float4 wa = *(const float4*)(fww + s0), wb = *(const float4*)(fww + s0 + 4);
        const bf16x8 af = pack8(bf2f((u16)b0[0]) * wa.x, bf2f((u16)b0[1]) * wa.y, bf2f((u16)b0[2]) * wa.z, bf2f((u16)b0[3]) * wa.w,
                                bf2f((u16)b1[0]) * wb.x, bf2f((u16)b1[1]) * wb.y, bf2f((u16)b1[2]) * wb.z, bf2f((u16)b1[3]) * wb.w);
#pragma unroll
        for (int pt = 0; pt < 4; ++pt) st[pt] = __builtin_amdgcn_mfma_f32_16x16x32_bf16(af, xf[pt], st[pt], 0, 0, 0);
      }
      if (kk >= kk_lo && kk <= kk_hi) {
        const uint4 gq = (kk == 0) ? gq0 : (kk == 1) ? gq1 : (kk == 2) ? gq2 : gq3;
        const float gv[8] = {bflo(gq.x), bfhi(gq.x), bflo(gq.y), bfhi(gq.y), bflo(gq.z), bfhi(gq.z), bflo(gq.w), bfhi(gq.w)};
        float mv[8];
        if (kk == (it >> 1)) {
          const float4 ca = *(const float4*)(fcum + s0), cb = *(const float4*)(fcum + s0 + 4);
          const float4 da = *(const float4*)(fdt + s0), db = *(const float4*)(fdt + s0 + 4);
          const float cs[8] = {ca.x, ca.y, ca.z, ca.w, cb.x, cb.y, cb.z, cb.w};
          const float ds[8] = {da.x, da.y, da.z, da.w, db.x, db.y, db.z, db.w};
#pragma unroll
          for (int e = 0; e < 8; ++e) {
            const int ss = s0 + e;
            const bool ok = dir ? (ss >= ii) : (ss <= ii);
            mv[e] = ok ? gv[e] * __expf(cum_i - cs[e]) * ds[e] : 0.f;
          }
        } else {
          const float ai = __expf(cum_i - fcum[dir ? kk * 32 : kk * 32 + 31]);
          const float4 ea = *(const float4*)(fee + s0), eb = *(const float4*)(fee + s0 + 4);
          mv[0] = gv[0] * ai * ea.x; mv[1] = gv[1] * ai * ea.y; mv[2] = gv[2] * ai * ea.z; mv[3] = gv[3] * ai * ea.w;
          mv[4] = gv[4] * ai * eb.x; mv[5] = gv[5] * ai * eb.y; mv[6] = gv[6] * ai * eb.z; mv[7] = gv[7] * ai * eb.w;
        }
        const bf16x8 mf = pack8(mv[0], mv[1], mv[2], mv[3], mv[4], mv[5], mv[6], mv[7]);
#pragma unroll
        for (int pt = 0; pt < 4; ++pt) y1[pt] = __builtin_amdgcn_mfma_f32_16x16x32_bf16(xf[pt], mf, y1[pt], 0, 0, 0);
      }
      {
        const bf16x8 cfk = (kk == 0) ? cf0 : (kk == 1) ? cf1 : (kk == 2) ? cf2 : cf3;
#pragma unroll
        for (int pt = 0; pt < 4; ++pt) {
          const bf16x8 sf = *(const bf16x8*)(Sb + (pt * 16 + fr) * LDP + kk * 32 + fq * 8);
          y2[pt] = __builtin_amdgcn_mfma_f32_16x16x32_bf16(sf, cfk, y2[pt], 0, 0, 0);
        }
      }
    }
    {
      const float ec = __expf(cum_i);
#pragma unroll
      for (int pt = 0; pt < 4; ++pt) {
        yp[pt][0] = pk2(y1[pt][0] + ec * y2[pt][0], y1[pt][1] + ec * y2[pt][1]);
        yp[pt][1] = pk2(y1[pt][2] + ec * y2[pt][2], y1[pt][3] + ec * y2[pt][3]);
      }
    }
  }
  {
    const int chp = dir ? 0 : (nch - 1);
    const size_t tbp = (size_t)b * S + (size_t)chp * 128;
#pragma unroll
    for (int pt = 0; pt < 4; pt += 2) {
      const uint2 ya = make_uint2(yp[pt][0], yp[pt][1]), yb2 = make_uint2(yp[pt + 1][0], yp[pt + 1][1]);
      *(uint4*)(yout + (tbp + it * 16 + fr) * DI + h * 64 + (pt + (fq & 1)) * 16 + (fq & ~1) * 4) = swap_pair(ya, yb2);
    }
  }
  __builtin_amdgcn_s_setprio(0);
  __syncthreads();
}

__device__ __forceinline__ void attn_item(const Params& P, const int pass, const int item, const int wvi) {
  unsigned char* ws = wsp_plain(P);
  const int tid = tidx(wvi), lane = tid & 63, w = wvi, fr = lane & 15, fq = lane >> 4;
  const int S = (pass == 0) ? 2048 : 16384, nbs = S >> 7;
  const int h = item & 15, blk = item >> 4, kvh = h >> 2;
  const int nb = blk % nbs, seqbase = (blk / nbs) * S;
  const int qb = blk * 128;
  constexpr int LDV = 144;
  constexpr int ATT_SET = 128 * LDP * 2 + 128 * LDV * 2;
  float* fb = (float*)(smem + 2 * ATT_SET);
  u16* qbuf = (u16*)(ws + OFF_Q);
  const u16* kbuf = (const u16*)(ws + OFF_K);
  const u16* vbuf = (const u16*)(ws + OFF_V);
  if (tid < 257) fb[tid] = lptr(P.rel_bias)[(int)P.bucket[tid] * 16 + h];
  bf16x8 qf[4];
#pragma unroll
  for (int kk = 0; kk < 4; ++kk) qf[kk] = __builtin_bit_cast(bf16x8, ldnt4u(qbuf + (size_t)(qb + w * 16 + fr) * DM + h * 128 + kk * 32 + fq * 8));
  float mrun = lptr(P.attn_sink)[h], lrun = 1.f;
  f32x4 oacc[8];
#pragma unroll
  for (int i = 0; i < 8; ++i) oacc[i] = f32x4{0.f, 0.f, 0.f, 0.f};
  const float scale = 0.08838834764831845f;
  const int qi = w * 16 + fr;
  const int kt_lo = (nb == 0) ? 1 : 0, kt_hi = (nb == nbs - 1) ? 1 : 2;
  uint4 pk0, pk1, pk2_, pk3, pv0, pv1, pv2, pv3;
#define ATT_LD(i, RK, RV) do { const int q = tid + NTHR * (i), row = q >> 4, c16 = q & 15; \
      const size_t tok = (size_t)seqbase + (size_t)(nb - 1 + ktn_) * 128 + row; \
      RK = *(const uint4*)(kbuf + tok * 512 + kvh * 128 + c16 * 8); \
      RV = *(const uint4*)(vbuf + tok * 512 + kvh * 128 + c16 * 8); } while (0)
#define ATT_ISSUE(kt_) do { const int ktn_ = (kt_); ATT_LD(0, pk0, pv0); ATT_LD(1, pk1, pv1); ATT_LD(2, pk2_, pv2); ATT_LD(3, pk3, pv3); } while (0)
#define ATT_ST(i, RK, RV) do { const int q = tid + NTHR * (i), row = q >> 4, c16 = q & 15; \
      *(uint4*)(Ks + row * LDP + c16 * 8) = RK; *(uint4*)(Vs + row * LDV + c16 * 8) = RV; } while (0)
  if (w >= 4) __builtin_amdgcn_s_setprio(1);
  ATT_ISSUE(kt_lo);
  for (int kt = kt_lo; kt <= kt_hi; ++kt) {
    u16* Ks = (u16*)(smem + (kt & 1) * ATT_SET);
    u16* Vs = Ks + 128 * LDP;
    ATT_ST(0, pk0, pv0); ATT_ST(1, pk1, pv1); ATT_ST(2, pk2_, pv2); ATT_ST(3, pk3, pv3);
    __syncthreads();
    ATT_ISSUE((kt < kt_hi) ? kt + 1 : kt);
    f32x4 sc[8];
    float mx = -INFINITY;
#pragma unroll
    for (int t8 = 0; t8 < 8; ++t8) {
      f32x4 a = f32x4{0.f, 0.f, 0.f, 0.f};
#pragma unroll
      for (int kk = 0; kk < 4; ++kk) {
        bf16x8 kf = *(const bf16x8*)(Ks + (t8 * 16 + fr) * LDP + kk * 32 + fq * 8);
        a = __builtin_amdgcn_mfma_f32_16x16x32_bf16(kf, qf[kk], a, 0, 0, 0);
      }
#pragma unroll
      for (int j = 0; j < 4; ++j) {
        const int rel = (kt - 1) * 128 + t8 * 16 + fq * 4 + j - qi;
        const bool ok = (rel >= -128) && (rel <= 128);
        const int ri = ok ? rel + 128 : 0;
        const float v = ok ? (a[j] * scale + fb[ri]) : -INFINITY;
        a[j] = v;
        mx = fmaxf(mx, v);
      }
      sc[t8] = a;
    }
    mx = fmaxf(mx, shfl_src(mx, lane ^ 16));
    mx = fmaxf(mx, shfl_src(mx, lane ^ 32));
    const float mnew = fmaxf(mrun, mx);
    const float alpha = __expf(mrun - mnew);
    float psum = 0.f;
#pragma unroll
    for (int t8 = 0; t8 < 8; ++t8)
#pragma unroll
      for (int j = 0; j < 4; ++j) { const float pv = __expf(sc[t8][j] - mnew); sc[t8][j] = pv; psum += pv; }
    psum += shfl_src(psum, lane ^ 16);
    psum += shfl_src(psum, lane ^ 32);
    lrun = lrun * alpha + psum;
    mrun = mnew;
#pragma unroll
    for (int d8 = 0; d8 < 8; ++d8)
#pragma unroll
      for (int j = 0; j < 4; ++j) oacc[d8][j] *= alpha;
#pragma unroll
    for (int kp = 0; kp < 4; ++kp) {
      const bf16x8 pf = pack8(sc[2 * kp][0], sc[2 * kp][1], sc[2 * kp][2], sc[2 * kp][3],
                              sc[2 * kp + 1][0], sc[2 * kp + 1][1], sc[2 * kp + 1][2], sc[2 * kp + 1][3]);
#pragma unroll
      for (int d8 = 0; d8 < 8; ++d8) {
        const u16* va = Vs + (kp * 32 + fq * 4 + (fr >> 2)) * LDV + d8 * 16 + (fr & 3) * 4;
        s16x4 v0 = ldtr(va), v1 = ldtr(va + 16 * LDV);
        oacc[d8] = __builtin_amdgcn_mfma_f32_16x16x32_bf16(cat8(v0, v1), pf, oacc[d8], 0, 0, 0);
      }
    }
  }
  const float linv = 1.f / lrun;
#pragma unroll
  for (int d8 = 0; d8 < 8; d8 += 2) {
    uint2 oa, ob;
    oa.x = pk2(oacc[d8][0] * linv, oacc[d8][1] * linv); oa.y = pk2(oacc[d8][2] * linv, oacc[d8][3] * linv);
    ob.x = pk2(oacc[d8 + 1][0] * linv, oacc[d8 + 1][1] * linv); ob.y = pk2(oacc[d8 + 1][2] * linv, oacc[d8 + 1][3] * linv);
    *(uint4*)(qbuf + (size_t)(qb + w * 16 + fr) * DM + h * 128 + (d8 + (fq & 1)) * 16 + (fq & ~1) * 4) = swap_pair(oa, ob);
  }
  __builtin_amdgcn_s_setprio(0);
  __syncthreads();
}

__device__ __forceinline__ void mixer_phase(const Params& P, const int pass, const int wvi) {
  __shared__ int s_item;
  int* ctr = (int*)(wsp_plain(P) + OFF_CTL) + pass * 8;
  const int tidm = tidx(wvi);
  const int n_ssd_q = (pass == 0) ? 128 : 16;
  const int n_mix_q = n_ssd_q + 256;
  const int n_gate_q = n_mix_q + 128;
  const int total_q = n_gate_q + 8;
  const int myq = (int)(xb_xcc_id() & 7u);
  for (int qq = 0; qq < 8; ++qq) {
    const int q = (myq + qq) & 7;
    while (true) {
      if (tidm == 0) s_item = atomicAdd(ctr + q, 1);
      __syncthreads();
      const int itx = s_item;
      __syncthreads();
      if (itx >= total_q) break;
      if (itx < n_ssd_q) {
        int b, combo;
        if (pass == 0) { b = q; combo = itx >> 3; } else { b = 0; combo = 2 * q + (itx >> 3); }
        const int g = combo >> 1, dir = combo & 1, h = g * 8 + (itx & 7);
        ssd_item(P, pass, (b << 7) | (h << 1) | dir, wvi);
      } else if (itx < n_mix_q) {
        const int a = itx - n_ssd_q;
        attn_item(P, pass, ((q * 16 + (a >> 4)) << 4) | (a & 15), wvi);
      } else if (itx < n_gate_q) {
        const int gu = itx - n_mix_q;
        const int u = (q * 2 + (gu >> 6)) * 64 + (gu & 63);
        gemm_phase<1>(P, pass, wvi, u, 1 << 20, u + 1);
        __syncthreads();
      } else {
        const int u = 15 * 64 + q * 8 + (itx - n_gate_q);
        gemm_phase<0>(P, pass, wvi, u, 1 << 20, u + 1);
        __syncthreads();
      }
    }
  }
}

__device__ __forceinline__ void combine_phase(const Params& P, const int wvi) {
  unsigned char* ws = wsp(P);
  const int tid = tidx(wvi);
  const int lane = tid & 63, wv = __builtin_amdgcn_readfirstlane(tid >> 6);
  const float* d_skip = lptr(P.d_skip);
  const float* ssm_norm_w = lptr(P.ssm_norm_w);
  u16* yf = (u16*)(ws + OFF_RA);
  const u16* yb = (const u16*)(ws + OFF_YB);
  const u16* xc = (const u16*)(ws + OFF_RB);
  const u16* zb = (const u16*)(ws + OFF_Z);
  const int l16 = lane & 15, sub = lane >> 4;
  const int g = ((blockIdx.x * 8 + wv) * 4 + sub) & 7;
  const int c0 = g * 512 + l16 * 8;
  float4 nw0[4], nw1[4];
  float dsk[4];
#pragma unroll
  for (int j = 0; j < 4; ++j) {
    nw0[j] = *(const float4*)(ssm_norm_w + c0 + j * 128);
    nw1[j] = *(const float4*)(ssm_norm_w + c0 + j * 128 + 4);
    dsk[j] = d_skip[(c0 + j * 128) >> 6];
  }
  for (int it4 = (blockIdx.x * 8 + wv) * 4; it4 < PT * 8; it4 += gridDim.x * 8 * 4) {
    const int it = it4 + sub;
    const int tok = it >> 3;
    uint4 ra[4], rb[4], rx[4], rz[4];
#pragma unroll
    for (int j = 0; j < 4; ++j) {
      const int c = c0 + j * 128;
      ra[j] = ldnt4u(yf + (size_t)tok * DI + c);
      rb[j] = ldnt4u(yb + (size_t)tok * DI + c);
      rx[j] = ldnt4u(xc + (size_t)tok * CONVD + c);
      rz[j] = ldnt4u(zb + (size_t)tok * DI + c);
    }
    float v[4][8];
    float ss = 0.f;
#pragma unroll
    for (int j = 0; j < 4; ++j) {
      const float D = dsk[j];
      const uint4 a = ra[j], b = rb[j], x = rx[j], z = rz[j];
      v[j][0] = (bflo(a.x) + bflo(b.x) + bflo(x.x) * D) * siluf_(bflo(z.x));
      v[j][1] = (bfhi(a.x) + bfhi(b.x) + bfhi(x.x) * D) * siluf_(bfhi(z.x));
      v[j][2] = (bflo(a.y) + bflo(b.y) + bflo(x.y) * D) * siluf_(bflo(z.y));
      v[j][3] = (bfhi(a.y) + bfhi(b.y) + bfhi(x.y) * D) * siluf_(bfhi(z.y));
      v[j][4] = (bflo(a.z) + bflo(b.z) + bflo(x.z) * D) * siluf_(bflo(z.z));
      v[j][5] = (bfhi(a.z) + bfhi(b.z) + bfhi(x.z) * D) * siluf_(bfhi(z.z));
      v[j][6] = (bflo(a.w) + bflo(b.w) + bflo(x.w) * D) * siluf_(bflo(z.w));
      v[j][7] = (bfhi(a.w) + bfhi(b.w) + bfhi(x.w) * D) * siluf_(bfhi(z.w));
#pragma unroll
      for (int e = 0; e < 8; ++e) ss += v[j][e] * v[j][e];
    }
#pragma unroll
    for (int o = 8; o > 0; o >>= 1) ss += shfl_src(ss, lane ^ o);
    const float rstd = rsqrtf(ss * (1.f / 512.f) + EPS);
#pragma unroll
    for (int j = 0; j < 4; ++j) {
      const int c = c0 + j * 128;
      const float4 w0 = nw0[j], w1 = nw1[j];
      uint4 o;
      o.x = pk2(v[j][0] * rstd * w0.x, v[j][1] * rstd * w0.y); o.y = pk2(v[j][2] * rstd * w0.z, v[j][3] * rstd * w0.w);
      o.z = pk2(v[j][4] * rstd * w1.x, v[j][5] * rstd * w1.y); o.w = pk2(v[j][6] * rstd * w1.z, v[j][7] * rstd * w1.w);
      *(uint4*)(yf + (size_t)tok * DI + c) = o;
    }
  }
}

__global__ void __launch_bounds__(NTHR) fwd_megakernel(const Params P) {
  cg::grid_group grid = cg::this_grid();
  __shared__ uint4 xb_words;
  __shared__ int s_vb[4];
  const int wvi = __builtin_amdgcn_readfirstlane((int)(threadIdx.x >> 6));
  if (threadIdx.x == 0) xb_words = make_uint4(0u, 0u, 0u, 0u);
  __syncthreads();
  (void)xcd_barrier_post((unsigned*)(wsp_plain(P) + OFF_CTL + 65536), (volatile LAS unsigned*)&xb_words, wvi);
  if (threadIdx.x == 0) {
    const unsigned x = xb_xcc_id() & 7u;
    s_vb[1] = (int)x;
    s_vb[2] = (int)atomicAdd((unsigned*)(P.ws + OFF_CTL + 8192) + x, 1u);
  }
  phase0(P, wvi);
  if (P.ws == nullptr) grid.sync();
  xcd_barrier(P, (volatile LAS unsigned*)&xb_words, wvi);
  if (threadIdx.x == 0) {
    bool even = (gridDim.x & 7u) == 0u;
    for (int j = 0; j < 8; ++j)
      even = even && (__hip_atomic_load((unsigned*)(P.ws + OFF_CTL + 8192) + j, __ATOMIC_RELAXED, __HIP_MEMORY_SCOPE_AGENT) == gridDim.x / 8u);
    s_vb[0] = even ? (s_vb[1] + 8 * s_vb[2]) : (int)blockIdx.x;
  }
  __syncthreads();
  for (int pass = 0; pass < NPASS; ++pass) {
    rmsnorm_rows<false>(pass_xin(P, pass), P.mix_norm_w, (u16*)(wsp(P) + OFF_XN), nullptr, wvi);
    xcd_barrier(P, (volatile LAS unsigned*)&xb_words, wvi);
    gemm_phase<0>(P, pass, wvi, __builtin_amdgcn_readfirstlane(s_vb[0]), 0, 0, 15);
    xcd_barrier(P, (volatile LAS unsigned*)&xb_words, wvi);
    conv_phase(P, pass, wvi);
    xcd_barrier(P, (volatile LAS unsigned*)&xb_words, wvi);
    cb_phase(P, wvi);
    xcd_barrier(P, (volatile LAS unsigned*)&xb_words, wvi);
    mixer_phase(P, pass, wvi);
    xcd_barrier(P, (volatile LAS unsigned*)&xb_words, wvi);
    combine_phase(P, wvi);
    xcd_barrier(P, (volatile LAS unsigned*)&xb_words, wvi);
    gemm_phase<2>(P, pass, wvi, __builtin_amdgcn_readfirstlane(s_vb[0]));
    gemm_phase<6>(P, pass, wvi, __builtin_amdgcn_readfirstlane(s_vb[0]));
    xcd_barrier(P, (volatile LAS unsigned*)&xb_words, wvi);
    gemm_phase<3>(P, pass, wvi, __builtin_amdgcn_readfirstlane(s_vb[0]));
    xcd_barrier(P, (volatile LAS unsigned*)&xb_words, wvi);
    rmsnorm_rows_bf16<false>((const u16*)(wsp(P) + OFF_RB), P.ffn_norm_w, (u16*)(wsp(P) + OFF_RB + 64 * MiB), nullptr, wvi);
    xcd_barrier(P, (volatile LAS unsigned*)&xb_words, wvi);
    gemm_phase<4>(P, pass, wvi, __builtin_amdgcn_readfirstlane(s_vb[0]));
    xcd_barrier(P, (volatile LAS unsigned*)&xb_words, wvi);
    gemm_phase<5>(P, pass, wvi, __builtin_amdgcn_readfirstlane(s_vb[0]));
    xcd_barrier(P, (volatile LAS unsigned*)&xb_words, wvi);
    rmsnorm_rows_bf16<true>((const u16*)(wsp(P) + OFF_RB), P.final_norm_w, nullptr, pass_out(P, pass), wvi);
  }
}

static void fill_buckets(unsigned char* bk) {
  for (int i = 0; i < 257; ++i) {
    int rel = i - 128;
    int half = 16, max_exact = 8;
    int ret = (rel > 0) ? half : 0;
    int n = rel < 0 ? -rel : rel;
    int nn = n > 1 ? n : 1;
    int large = max_exact + (int)(std::log((double)nn / max_exact) / std::log(128.0 / max_exact) * (half - max_exact));
    if (large > half - 1) large = half - 1;
    bk[i] = (unsigned char)(ret + ((n < max_exact) ? n : large));
  }
}

extern "C" void kernel_launch(void* const* d_in, const int* in_sizes, int n_in, void* d_out, int out_size, void* d_ws,
                              size_t ws_size, hipStream_t stream) {
  static int grid_blocks = 0;
  if (grid_blocks == 0) {
    if (ws_size < WS_NEED) { fprintf(stderr, "kernel_launch: workspace too small: %zu < %zu\n", ws_size, (size_t)WS_NEED); grid_blocks = -1; return; }
    int dev = 0, cus = 0, per_cu = 0;
    hipGetDevice(&dev);
    hipDeviceGetAttribute(&cus, hipDeviceAttributeMultiprocessorCount, dev);
    if (hipFuncSetAttribute((const void*)fwd_megakernel, hipFuncAttributeMaxDynamicSharedMemorySize, LDS_BYTES) != hipSuccess) {
      fprintf(stderr, "kernel_launch: hipFuncSetAttribute failed\n"); grid_blocks = -1; return;
    }
    if (hipOccupancyMaxActiveBlocksPerMultiprocessor(&per_cu, (const void*)fwd_megakernel, NTHR, LDS_BYTES) != hipSuccess || per_cu < 1) {
      fprintf(stderr, "kernel_launch: occupancy query says %d blocks/CU\n", per_cu); per_cu = 1;
    }
    (void)hipGetLastError();
    grid_blocks = cus * 1;
  }
  if (grid_blocks < 0) return;
  Params p{};
  const float** pp = (const float**)&p;
  for (int i = 0; i < 19; ++i) pp[i] = (const float*)d_in[i];
  p.out = (float*)d_out;
  p.ws = (unsigned char*)d_ws;
  fill_buckets(p.bucket);
  if (hipMemsetAsync((unsigned char*)d_ws + OFF_CTL, 0, 131072, stream) != hipSuccess) { fprintf(stderr, "kernel_launch: memset of control words failed\n"); return; }
  void* args[] = {&p};
  hipError_t e = hipLaunchCooperativeKernel((const void*)fwd_megakernel, dim3(grid_blocks), dim3(NTHR), args, LDS_BYTES, stream);
  if (e != hipSuccess) fprintf(stderr, "cooperative launch failed: %s (grid %d)\n", hipGetErrorString(e), grid_blocks);
}
```

```cpp
#include <hip/hip_runtime.h>
#include <hip/hip_bf16.h>
#include <hip/hip_cooperative_groups.h>
#include <cstdio>
#include <cmath>
namespace cg = cooperative_groups;

typedef unsigned short u16;
using bf16x8 = __attribute__((ext_vector_type(8))) short;
using s16x4 = __attribute__((ext_vector_type(4))) short;
using f32x4 = __attribute__((ext_vector_type(4))) float;
typedef __bf16 bf2_t __attribute__((ext_vector_type(2)));

constexpr int DM = 2048, DI = 4096, CONVD = 6144, DFF = 5632;
constexpr int PT = 16384;
constexpr int NPASS = 3;
constexpr int NIN = 13568;
constexpr int WIN_LD = 17536;
constexpr float EPS = 1e-6f;
constexpr int NTHR = 512;

constexpr size_t MiB = (size_t)1 << 20;
constexpr size_t OFF_WIN = 0, OFF_WGATE = 53 * MiB, OFF_WSSM = 69 * MiB, OFF_WATTN = 85 * MiB, OFF_WOUT = 93 * MiB,
                 OFF_WFFI = 101 * MiB, OFF_WFFO = 145 * MiB, OFF_RA = 167 * MiB, OFF_RB = 359 * MiB, OFF_XN = 551 * MiB,
                 OFF_Z = 615 * MiB, OFF_Q = 743 * MiB, OFF_K = 807 * MiB, OFF_V = 823 * MiB, OFF_DTR = 839 * MiB,
                 OFF_DTT = 847 * MiB, OFF_CUM = 855 * MiB, OFF_YB = 863 * MiB, OFF_CTL = 991 * MiB, OFF_WW = 992 * MiB, OFF_EE = 1000 * MiB,
                 WS_NEED = 1008 * MiB;
constexpr int LDS_BYTES = 145408;

struct Params {
  const float *x_prompt, *x_sample, *mix_norm_w, *w_in, *conv_w, *conv_b, *dt_bias, *a_log, *d_skip, *ssm_norm_w,
      *w_ssm, *rel_bias, *attn_sink, *w_attn, *w_out, *ffn_norm_w, *w_ffn_in, *w_ffn_out, *final_norm_w;
  float* out;
  unsigned char* ws;
  unsigned char bucket[264];
};

extern __shared__ __attribute__((aligned(16))) unsigned char smem[];

__device__ __forceinline__ int tidx(const int wvi) {
  int l;
  asm volatile("v_mbcnt_lo_u32_b32 %0, -1, 0\n\tv_mbcnt_hi_u32_b32 %0, -1, %0" : "=v"(l));
  return wvi * 64 + l;
}
template <class T>
__device__ __forceinline__ T* lptr(T* p) {
  return p;
}
__device__ __forceinline__ const float* pass_xin(const Params& P, int pass) {
  const float* base = (pass == 0) ? P.x_prompt : P.x_sample;
  const unsigned off = (pass == 0) ? 0u : (unsigned)(pass - 1) * (unsigned)(PT * DM);
  return lptr(base + off);
}
__device__ __forceinline__ float* pass_out(const Params& P, int pass) {
  const unsigned off = (unsigned)pass * (unsigned)(PT * DM);
  return lptr(P.out + off);
}
__device__ __forceinline__ unsigned char* wsp_plain(const Params& P) { return P.ws; }
__device__ __forceinline__ unsigned char* wsp(const Params& P) { return P.ws; }
__device__ __forceinline__ unsigned pk2(float a, float b) {
  bf2_t v; v[0] = (__bf16)a; v[1] = (__bf16)b;
  return __builtin_bit_cast(unsigned, v);
}
__device__ __forceinline__ float bf2f(u16 h) { return __uint_as_float(((unsigned)h) << 16); }
__device__ __forceinline__ float bflo(unsigned u) { return __uint_as_float(u << 16); }
__device__ __forceinline__ float bfhi(unsigned u) { return __uint_as_float(u & 0xffff0000u); }
__device__ __forceinline__ float sigmoidf_(float x) { return __builtin_amdgcn_rcpf(1.f + __expf(-x)); }
__device__ __forceinline__ float siluf_(float x) { return x * __builtin_amdgcn_rcpf(1.f + __expf(-x)); }
__device__ __forceinline__ float shfl_src(float v, int src) {
  return __int_as_float(__builtin_amdgcn_ds_bpermute(src << 2, __float_as_int(v)));
}
__device__ __forceinline__ float4 ldnt4(const float* p) {
  typedef float f4v __attribute__((ext_vector_type(4)));
  const f4v v = __builtin_nontemporal_load((const f4v*)p);
  return make_float4(v[0], v[1], v[2], v[3]);
}
__device__ __forceinline__ uint4 ldnt4u(const u16* p) {
  typedef unsigned u4v __attribute__((ext_vector_type(4)));
  const u4v v = __builtin_nontemporal_load((const u4v*)p);
  return make_uint4(v[0], v[1], v[2], v[3]);
}
__device__ __forceinline__ float wave_sum(float v, int lane) {
#pragma unroll
  for (int o = 32; o > 0; o >>= 1) v += shfl_src(v, lane ^ o);
  return v;
}
__device__ __forceinline__ s16x4 ldtr(const u16* p) {
  return __builtin_amdgcn_ds_read_tr16_b64_v4i16((__attribute__((address_space(3))) s16x4*)p);
}
__device__ __forceinline__ bf16x8 cat8(s16x4 a, s16x4 b) {
  bf16x8 r; r[0] = a[0]; r[1] = a[1]; r[2] = a[2]; r[3] = a[3]; r[4] = b[0]; r[5] = b[1]; r[6] = b[2]; r[7] = b[3];
  return r;
}
__device__ __forceinline__ bf16x8 pack8(float a0, float a1, float a2, float a3, float a4, float a5, float a6, float a7) {
  uint4 u; u.x = pk2(a0, a1); u.y = pk2(a2, a3); u.z = pk2(a4, a5); u.w = pk2(a6, a7);
  return __builtin_bit_cast(bf16x8, u);
}


#define XB_TMO      128
#define XB_XCNT(j)  (256  + 64 * (j))
#define XB_XSUB(j)  (1280 + 64 * (j))
#define XB_XGEN(j)  (2304 + 64 * (j))
#define XB_TOP      3328
#define XB_TOPGEN   3392
#define XCD_BAR_WORDS 3456
#define XB_SPIN_CAP (1u << 22)
#define LAS __attribute__((address_space(3)))
__device__ __forceinline__ unsigned xb_ld(unsigned* p) { return __hip_atomic_load(p, __ATOMIC_RELAXED, __HIP_MEMORY_SCOPE_AGENT); }
__device__ __forceinline__ unsigned xb_add(unsigned* p, unsigned v) { return __hip_atomic_fetch_add(p, v, __ATOMIC_RELAXED, __HIP_MEMORY_SCOPE_AGENT); }
__device__ __forceinline__ unsigned xb_xcc_id() { return (unsigned)__builtin_amdgcn_s_getreg((3 << 11) | 20) & 0xFu; }
#define XB_SPIN(cond, bar) do { unsigned _sp = 0; while (cond) { __builtin_amdgcn_s_sleep(1); \
    if ((++_sp & 255u) == 0u) { if (xb_ld(&(bar)[XB_TMO])) break; if (_sp > XB_SPIN_CAP) { atomicAdd(&(bar)[XB_TMO], 1u); break; } } } } while (0)
struct XcdBarrier { unsigned* bar; unsigned x; volatile LAS unsigned* st; };
__device__ __forceinline__ XcdBarrier xcd_barrier_post(unsigned* bar, volatile LAS unsigned* st, const int wvi) {
  XcdBarrier b; b.bar = bar; b.x = xb_xcc_id(); b.st = st;
  if (tidx(wvi) == 0) (void)xb_add(&bar[XB_XCNT(b.x)], 1u);
  return b;
}
__device__ __forceinline__ void xcd_barrier_complete(unsigned* bar, unsigned x, unsigned& nloc, unsigned& nx) {
  const unsigned G = gridDim.x * gridDim.y * gridDim.z;
  unsigned sum, cnt, mine, sp = 0u;
  for (;;) {
    sum = 0u; cnt = 0u; mine = 0u;
#pragma unroll
    for (unsigned j = 0; j < 16; ++j) { const unsigned c = xb_ld(&bar[XB_XCNT(j)]); sum += c; cnt += (c > 0u) ? 1u : 0u; mine = (j == x) ? c : mine; }
    if (sum == G) break;
    __builtin_amdgcn_s_sleep(1);
    if ((++sp & 255u) == 0u) { if (xb_ld(&bar[XB_TMO])) break; if (sp > XB_SPIN_CAP) { atomicAdd(&bar[XB_TMO], 1u); break; } }
  }
  nloc = mine > 0u ? mine : 1u; nx = cnt > 0u ? cnt : 1u;
}
__device__ __forceinline__ void xcd_barrier(const Params& P, volatile LAS unsigned* st, const int wvi) {
  XcdBarrier b; b.bar = (unsigned*)(wsp_plain(P) + OFF_CTL + 65536); b.x = xb_xcc_id(); b.st = st;
  asm volatile("s_waitcnt vmcnt(0)" ::: "memory");
  __syncthreads();
  if (tidx(wvi) == 0) {
    unsigned* bar = b.bar;
    __builtin_amdgcn_s_waitcnt(0);
    unsigned nloc = b.st[0], nx = b.st[1];
    if (nloc == 0u) { xcd_barrier_complete(bar, b.x, nloc, nx); b.st[0] = nloc; b.st[1] = nx; }
    const unsigned old = xb_add(&bar[XB_XSUB(b.x)], 1u);
    const unsigned gen = old / nloc;
    if (old + 1u == (gen + 1u) * nloc) {
      __builtin_amdgcn_fence(__ATOMIC_RELEASE, "agent");
      asm volatile("s_waitcnt vmcnt(0)" ::: "memory");
      const unsigned og = xb_add(&bar[XB_TOP], 1u);
      const unsigned tg = og / nx;
      if (og + 1u == (tg + 1u) * nx) xb_add(&bar[XB_TOPGEN], 1u);
      else XB_SPIN(xb_ld(&bar[XB_TOPGEN]) == tg, bar);
      __builtin_amdgcn_fence(__ATOMIC_ACQUIRE, "agent");
      xb_add(&bar[XB_XGEN(b.x)], 1u);
      asm volatile("s_waitcnt vmcnt(0)" ::: "memory");
    } else {
      XB_SPIN(xb_ld(&bar[XB_XGEN(b.x)]) == gen, bar);
      __builtin_amdgcn_fence(__ATOMIC_ACQUIRE, "agent");
      asm volatile("s_waitcnt vmcnt(0)" ::: "memory");
    }
  }
  __syncthreads();
}

__device__ __forceinline__ void wconv(const float* __restrict__ src, int ld, int col0, u16* __restrict__ dst, int drow0, int ncols, int K, int mode, const int wvi) {
  float* tile = (float*)smem;
  const int tid = tidx(wvi);
  const int nkt = K >> 6, nnt = ncols >> 6;
  for (int t = blockIdx.x; t < nkt * nnt; t += gridDim.x) {
    const int kt = t % nkt, nt = t / nkt;
    const int k0 = kt << 6, r0 = nt << 6;
    int sc0;
    if (mode == 0) sc0 = col0 + r0;
    else { int t256 = r0 >> 8, wi = r0 & 255; sc0 = (wi < 128) ? (t256 * 128 + wi) : (DFF + t256 * 128 + wi - 128); }
    __syncthreads();
#pragma unroll
    for (int i = 0; i < 2; ++i) {
      int kk = (tid >> 4) + 32 * i, nn = (tid & 15) * 4;
      float4 v = ldnt4(src + (size_t)(k0 + kk) * ld + sc0 + nn);
      tile[kk * 65 + nn] = v.x; tile[kk * 65 + nn + 1] = v.y; tile[kk * 65 + nn + 2] = v.z; tile[kk * 65 + nn + 3] = v.w;
    }
    __syncthreads();
    {
      int nn = tid >> 3, kq = (tid & 7) * 8;
      float f[8];
#pragma unroll
      for (int e = 0; e < 8; ++e) f[e] = tile[(kq + e) * 65 + nn];
      uint4 o; o.x = pk2(f[0], f[1]); o.y = pk2(f[2], f[3]); o.z = pk2(f[4], f[5]); o.w = pk2(f[6], f[7]);
      *(uint4*)(dst + (size_t)(drow0 + r0 + nn) * K + k0 + kq) = o;
    }
  }
  __syncthreads();
}

__device__ __forceinline__ void phase0(const Params& P, const int wvi) {
  unsigned char* ws = wsp(P);
  const int tid0 = tidx(wvi);
  u16* win = (u16*)(ws + OFF_WIN);
  wconv(P.w_in, WIN_LD, 0, win, 0, 4096, DM, 0, wvi);
  wconv(P.w_in, WIN_LD, 4096, win, 4096, 6144, DM, 0, wvi);
  wconv(P.w_in, WIN_LD, 10368, win, 10240, 2048, DM, 0, wvi);
  wconv(P.w_in, WIN_LD, 12416, win, 12288, 512, DM, 0, wvi);
  wconv(P.w_in, WIN_LD, 12928, win, 12800, 512, DM, 0, wvi);
  wconv(P.w_in, WIN_LD, 10240, win, 13312, 128, DM, 0, wvi);
  {
    uint4 z4 = make_uint4(0, 0, 0, 0);
    uint4* pz = (uint4*)(win + (size_t)13440 * DM);
    for (int i = blockIdx.x * NTHR + tid0; i < 128 * DM / 8; i += gridDim.x * NTHR) pz[i] = z4;
  }
  wconv(P.w_in, WIN_LD, 13440, (u16*)(ws + OFF_WGATE), 0, 4096, DM, 0, wvi);
  wconv(P.w_ssm, DM, 0, (u16*)(ws + OFF_WSSM), 0, DM, DI, 0, wvi);
  wconv(P.w_attn, DM, 0, (u16*)(ws + OFF_WATTN), 0, DM, DM, 0, wvi);
  wconv(P.w_out, DM, 0, (u16*)(ws + OFF_WOUT), 0, DM, DM, 0, wvi);
  wconv(P.w_ffn_in, 2 * DFF, 0, (u16*)(ws + OFF_WFFI), 0, 2 * DFF, DM, 1, wvi);
  wconv(P.w_ffn_out, DM, 0, (u16*)(ws + OFF_WFFO), 0, DM, DFF, 0, wvi);
  if (blockIdx.x == 0 && tid0 < 32) {
    int* ctr = (int*)(ws + OFF_CTL);
    __hip_atomic_store(&ctr[tid0], 0, __ATOMIC_RELAXED, __HIP_MEMORY_SCOPE_AGENT);
  }
}

template <bool OUTF32>
__device__ __forceinline__ void rmsnorm_rows(const float* src, const float* w, u16* dstb, float* dstf, const int wvi) {
  const int tid = tidx(wvi);
  const int lane = tid & 63, wv = __builtin_amdgcn_readfirstlane(tid >> 6);
  src = lptr(src); w = lptr(w); dstb = lptr(dstb); dstf = lptr(dstf);
  float4 gw[8];
#pragma unroll
  for (int i = 0; i < 8; ++i) gw[i] = *(const float4*)(w + i * 256 + lane * 4);
  for (int row = blockIdx.x * 8 + wv; row < PT; row += gridDim.x * 8) {
    const float* s = src + (size_t)row * DM;
    float4 v[8];
    float ss = 0.f;
#pragma unroll
    for (int i = 0; i < 8; ++i) {
      v[i] = ldnt4(s + i * 256 + lane * 4);
      ss += v[i].x * v[i].x + v[i].y * v[i].y + v[i].z * v[i].z + v[i].w * v[i].w;
    }
    ss = wave_sum(ss, lane);
    const float rstd = rsqrtf(ss * (1.f / DM) + EPS);
#pragma unroll
    for (int i = 0; i < 8; ++i) {
      const int c = i * 256 + lane * 4;
      const float4 g = gw[i];
      float o0 = v[i].x * rstd * g.x, o1 = v[i].y * rstd * g.y, o2 = v[i].z * rstd * g.z, o3 = v[i].w * rstd * g.w;
      if (OUTF32) {
        *(float4*)(dstf + (size_t)row * DM + c) = make_float4(o0, o1, o2, o3);
      } else {
        uint2 o; o.x = pk2(o0, o1); o.y = pk2(o2, o3);
        *(uint2*)(dstb + (size_t)row * DM + c) = o;
      }
    }
  }
}

template <bool OUTF32>
__device__ __forceinline__ void rmsnorm_rows_bf16(const u16* src, const float* w, u16* dst, float* dstf, const int wvi) {
  const int tid = tidx(wvi);
  const int lane = tid & 63, wv = __builtin_amdgcn_readfirstlane(tid >> 6);
  float4 gw0[4], gw1[4];
#pragma unroll
  for (int i = 0; i < 4; ++i) { gw0[i] = *(const float4*)(w + i * 512 + lane * 8); gw1[i] = *(const float4*)(w + i * 512 + lane * 8 + 4); }
  for (int row = blockIdx.x * 8 + wv; row < PT; row += gridDim.x * 8) {
    uint4 r[4];
    float ss = 0.f;
#pragma unroll
    for (int i = 0; i < 4; ++i) {
      r[i] = *(const uint4*)(src + (size_t)row * DM + i * 512 + lane * 8);
      const float f0 = bflo(r[i].x), f1 = bfhi(r[i].x), f2 = bflo(r[i].y), f3 = bfhi(r[i].y);
      const float f4 = bflo(r[i].z), f5 = bfhi(r[i].z), f6 = bflo(r[i].w), f7 = bfhi(r[i].w);
      ss += f0 * f0 + f1 * f1 + f2 * f2 + f3 * f3 + f4 * f4 + f5 * f5 + f6 * f6 + f7 * f7;
    }
    ss = wave_sum(ss, lane);
    const float rstd = rsqrtf(ss * (1.f / DM) + EPS);
#pragma unroll
    for (int i = 0; i < 4; ++i) {
      const int c = i * 512 + lane * 8;
      const float4 g0 = gw0[i], g1 = gw1[i];
      if (OUTF32) {
        float* po = dstf + (size_t)row * DM + c;
        *(float4*)po = make_float4(bflo(r[i].x) * rstd * g0.x, bfhi(r[i].x) * rstd * g0.y, bflo(r[i].y) * rstd * g0.z, bfhi(r[i].y) * rstd * g0.w);
        *(float4*)(po + 4) = make_float4(bflo(r[i].z) * rstd * g1.x, bfhi(r[i].z) * rstd * g1.y, bflo(r[i].w) * rstd * g1.z, bfhi(r[i].w) * rstd * g1.w);
      } else {
      uint4 o;
      o.x = pk2(bflo(r[i].x) * rstd * g0.x, bfhi(r[i].x) * rstd * g0.y);
      o.y = pk2(bflo(r[i].y) * rstd * g0.z, bfhi(r[i].y) * rstd * g0.w);
      o.z = pk2(bflo(r[i].z) * rstd * g1.x, bfhi(r[i].z) * rstd * g1.y);
      o.w = pk2(bflo(r[i].w) * rstd * g1.z, bfhi(r[i].w) * rstd * g1.w);
      *(uint4*)(dst + (size_t)row * DM + c) = o;
      }
    }
  }
}

__device__ __forceinline__ uint4 swap_pair(const uint2 a, const uint2 b) {
  const auto rx = __builtin_amdgcn_permlane16_swap(a.x, b.x, false, false);
  const auto ry = __builtin_amdgcn_permlane16_swap(a.y, b.y, false, false);
  return make_uint4(rx[0], ry[0], rx[1], ry[1]);
}

constexpr int BK = 64, HALF = 128, HT = HALF * BK;
__device__ __forceinline__ int lds_byte(int r, int c) {
  int st = (r >> 4) * 2 + (c >> 5), rr = r & 15, cc = c & 31, ob = rr * 64 + cc * 2;
  return st * 1024 + (ob ^ (((ob >> 9) & 1) << 5));
}
__device__ __forceinline__ void stage_rc(int b, int& R, int& C) {
  int st = b / 1024, sb = b % 1024, swz = sb ^ (((sb >> 9) & 1) << 5);
  R = (st >> 1) * 16 + swz / 64; C = (st & 1) * 32 + (swz % 64) / 2;
}

template <int PRE>
__device__ __forceinline__ void gemm_kloop(const u16* __restrict__ A, const u16* __restrict__ Bt, const int K, const int brow,
                                           const int bcol, const int brow_n, const int bcol_n, f32x4 (&acc)[2][2][4][2], const int tid,
                                           const int wvi) {
  u16* shm = (u16*)smem;
#define SA(b, h) (shm + ((b) * 2 + (h)) * HT)
#define SB(b, h) (shm + (4 + (b) * 2 + (h)) * HT)
#define STAGE(P_, BASE, br, kt) do { const u16* _gb = (BASE) + (long)(br) * K + (long)(kt) * BK; \
    _Pragma("unroll") for (int _i = 0; _i < 2; ++_i) { \
      __builtin_amdgcn_global_load_lds((const unsigned*)(_gb + (long)_i * 64 * K + lane_off), \
        (unsigned*)((char*)(P_) + lds_wbase + _i * 8192), 16, 0, 0); } } while (0)
#define LDA(dst, b, h) _Pragma("unroll") for (int m = 0; m < 4; ++m) _Pragma("unroll") for (int k = 0; k < 2; ++k) \
    dst[m][k] = *reinterpret_cast<const bf16x8*>((char*)SA(b, h) + lds_byte(wr * 64 + m * 16 + fr, k * 32 + fq * 8))
#define LDB(dst, b, h) _Pragma("unroll") for (int n = 0; n < 2; ++n) _Pragma("unroll") for (int k = 0; k < 2; ++k) \
    dst[n][k] = *reinterpret_cast<const bf16x8*>((char*)SB(b, h) + lds_byte(wc * 32 + n * 16 + fr, k * 32 + fq * 8))
#define MMA(ai, bj, At_, Bt_) do { __builtin_amdgcn_s_setprio(1); \
    _Pragma("unroll") for (int m = 0; m < 4; ++m) _Pragma("unroll") for (int n = 0; n < 2; ++n) _Pragma("unroll") for (int k = 0; k < 2; ++k) \
      acc[ai][bj][m][n] = __builtin_amdgcn_mfma_f32_16x16x32_bf16(At_[m][k], Bt_[n][k], acc[ai][bj][m][n], 0, 0, 0); \
    __builtin_amdgcn_s_setprio(0); } while (0)
#define WAIT_V(n) asm volatile("s_waitcnt vmcnt(" #n ")" ::: "memory")
#define WAIT_L(n) asm volatile("s_waitcnt lgkmcnt(" #n ")" ::: "memory")
#define BAR __builtin_amdgcn_s_barrier()
#define SCHED __builtin_amdgcn_sched_barrier(0)
  const int wid = wvi, lane = tid & 63, wr = wid >> 2, wc = wid & 3, fr = lane & 15, fq = lane >> 4;
  bf16x8 At[4][2], B0[2][2], B1[2][2];
  const int nt = K / BK;
  const unsigned lds_wbase = wid * 1024;
  unsigned lane_off;
  { int _r, _c; stage_rc(tid * 16, _r, _c); lane_off = (unsigned)(_r * K + _c); }
#define STAGEW(P_, BASE, cur, nxt, kt_) do { const bool _wr = (kt_) >= nt; \
    STAGE(P_, BASE, (_wr ? (nxt) : (cur)), (_wr ? (kt_) - nt : (kt_))); } while (0)
  if (PRE == 2) {
    STAGE(SB(0, 0), Bt, bcol, 0); STAGE(SA(0, 0), A, brow, 0);
    STAGE(SB(0, 1), Bt, bcol + HALF, 0); STAGE(SA(0, 1), A, brow + HALF, 0);
    if (wr == 1) BAR;
    WAIT_V(4); BAR;
    STAGE(SB(1, 0), Bt, bcol, 1); STAGE(SA(1, 0), A, brow, 1); STAGE(SB(1, 1), Bt, bcol + HALF, 1);
    WAIT_V(6); BAR;
    return;
  }
  for (int t = 0; t < nt; t += 2) {
    LDB(B0, 0, 0); SCHED; LDA(At, 0, 0); STAGE(SA(1, 1), A, brow + HALF, t + 1);
    WAIT_L(8); BAR; WAIT_L(0); MMA(0, 0, At, B0); BAR; SCHED;
    LDB(B1, 0, 1); STAGEW(SB(0, 0), Bt, bcol, bcol_n, t + 2);
    BAR; WAIT_L(0); MMA(0, 1, At, B1); BAR;
    LDA(At, 0, 1); STAGEW(SA(0, 0), A, brow, brow_n, t + 2);
    BAR; WAIT_L(0); MMA(1, 0, At, B0); BAR; SCHED;
    STAGEW(SB(0, 1), Bt, bcol + HALF, bcol_n + HALF, t + 2);
    WAIT_V(6); BAR; MMA(1, 1, At, B1); BAR;
    LDB(B0, 1, 0); SCHED; LDA(At, 1, 0); STAGEW(SA(0, 1), A, brow + HALF, brow_n + HALF, t + 2);
    WAIT_L(8); BAR; WAIT_L(0); MMA(0, 0, At, B0); BAR; SCHED;
    LDB(B1, 1, 1); STAGEW(SB(1, 0), Bt, bcol, bcol_n, t + 3);
    BAR; WAIT_L(0); MMA(0, 1, At, B1); BAR;
    LDA(At, 1, 1); STAGEW(SA(1, 0), A, brow, brow_n, t + 3);
    BAR; WAIT_L(0); MMA(1, 0, At, B0); BAR; SCHED;
    STAGEW(SB(1, 1), Bt, bcol + HALF, bcol_n + HALF, t + 3);
    WAIT_V(6); BAR; MMA(1, 1, At, B1); BAR;
  }
  if (wr == 0) BAR;
#undef STAGEW
#undef SA
#undef SB
#undef STAGE
#undef LDA
#undef LDB
#undef MMA
}

template <int MODE>
__device__ __forceinline__ void gemm_phase(const Params& P, const int pass, const int wvi, const int vb, const int u_stride_in = 0, const int u_end_in = 0,
                                           const int tn_skip = -1) {
  unsigned char* ws = wsp(P);
  const int tid = tidx(wvi);
  const u16 *W, *Act;
  int K, nN;
  if (MODE == 0) { W = (const u16*)(ws + OFF_WIN); Act = (const u16*)(ws + OFF_XN); K = DM; nN = NIN / 256; }
  else if (MODE == 1) { W = (const u16*)(ws + OFF_WGATE); Act = (const u16*)(ws + OFF_XN); K = DM; nN = 16; }
  else if (MODE == 2) { W = (const u16*)(ws + OFF_WSSM); Act = (const u16*)(ws + OFF_RA); K = DI; nN = 8; }
  else if (MODE == 6) { W = (const u16*)(ws + OFF_WATTN); Act = (const u16*)(ws + OFF_Q); K = DM; nN = 8; }
  else if (MODE == 3) { W = (const u16*)(ws + OFF_WOUT); Act = (const u16*)(ws + OFF_RB + 128 * MiB); K = DM; nN = 8; }
  else if (MODE == 4) { W = (const u16*)(ws + OFF_WFFI); Act = (const u16*)(ws + OFF_RB + 64 * MiB); K = DM; nN = 44; }
  else { W = (const u16*)(ws + OFF_WFFO); Act = (const u16*)(ws + OFF_RA); K = DFF; nN = 8; }
  const float* xin = pass_xin(P, pass);
  float* outp = pass_out(P, pass);
  const int nM = PT / 256;
  const int wid = wvi, lane = tid & 63, wr = wid >> 2, wc = wid & 3;
  const int nunits = u_end_in ? u_end_in : (tn_skip >= 0 ? (nN - 1) * nM : nN * nM);
  const int ustride = u_stride_in ? u_stride_in : (int)gridDim.x;
  if (vb < nunits) {
    f32x4 acc[2][2][4][2];
    gemm_kloop<2>(W, Act, K, (vb / nM + ((tn_skip >= 0 && vb / nM >= tn_skip) ? 1 : 0)) * 256, (vb % nM) * 256, 0, 0, acc, tid, wvi);
  for (int u = vb; u < nunits; u += ustride) {
    const int tm = u % nM, tn = u / nM + ((tn_skip >= 0 && u / nM >= tn_skip) ? 1 : 0);
    const int brow = tn * 256, bcol = tm * 256;
    const int un = u + ustride;
    const bool has_next = un < nunits;
    const int tn_n = un / nM + ((tn_skip >= 0 && un / nM >= tn_skip) ? 1 : 0);
    const int brow_n = has_next ? tn_n * 256 : brow, bcol_n = has_next ? (un % nM) * 256 : bcol;
#pragma unroll
    for (int a = 0; a < 2; ++a)
#pragma unroll
      for (int b = 0; b < 2; ++b)
#pragma unroll
        for (int m = 0; m < 4; ++m)
#pragma unroll
          for (int n = 0; n < 2; ++n) acc[a][b][m][n] = f32x4{0.f, 0.f, 0.f, 0.f};
    gemm_kloop<3>(W, Act, K, brow, bcol, brow_n, bcol_n, acc, tid, wvi);
#pragma unroll
    for (int a = 0; a < 2; ++a)
#pragma unroll
      for (int b = 0; b < 2; ++b)
#pragma unroll
        for (int m = 0; m < 4; ++m)
#pragma unroll
          for (int n = 0; n < 2; ++n) asm volatile("" : "+v"(acc[a][b][m][n]));
    int lane_e = lane;
    asm volatile("" : "+v"(lane_e));
    const int fr = lane_e & 15, fq = lane_e >> 4;
    if (MODE == 4) {
      u16* act = (u16*)(ws + OFF_RA);
      uint2 opend4[2];
#pragma unroll
      for (int bj = 0; bj < 2; ++bj)
#pragma unroll
        for (int m = 0; m < 4; ++m)
#pragma unroll
          for (int n = 0; n < 2; ++n) {
            int lane_i = lane_e;
            asm volatile("" : "+v"(lane_i));
            const int fr = lane_i & 15, fq = lane_i >> 4;
            const int nc = tn * 128 + wr * 64 + m * 16 + fq * 4;
            const int tok = bcol + bj * 128 + wc * 32 + n * 16 + fr;
            f32x4 g = acc[0][bj][m][n], up = acc[1][bj][m][n];
            uint2 o;
            o.x = pk2(siluf_(g[0]) * up[0], siluf_(g[1]) * up[1]);
            o.y = pk2(siluf_(g[2]) * up[2], siluf_(g[3]) * up[3]);
            if ((m & 1) == 0) opend4[n] = o;
            else {
              const int ncw = tn * 128 + wr * 64 + ((m & ~1) + (fq & 1)) * 16 + (fq & ~1) * 4;
              *(uint4*)(act + (size_t)tok * DFF + ncw) = swap_pair(opend4[n], o);
            }
          }
    } else {
      uint2 opend[2];
#pragma unroll
      for (int ai = 0; ai < 2; ++ai)
#pragma unroll
        for (int bj = 0; bj < 2; ++bj)
#pragma unroll
          for (int m = 0; m < 4; ++m)
#pragma unroll
            for (int n = 0; n < 2; ++n) {
              const int nc = brow + ai * 128 + wr * 64 + m * 16 + fq * 4;
              const int tok = bcol + bj * 128 + wc * 32 + n * 16 + fr;
              const int ncw = brow + ai * 128 + wr * 64 + ((m & ~1) + (fq & 1)) * 16 + (fq & ~1) * 4;
#define WIDE_STORE(BASE, LD, COFF, O) do { if ((m & 1) == 0) opend[n] = (O); \
                else *(uint4*)((BASE) + (size_t)tok * (LD) + (ncw - (COFF))) = swap_pair(opend[n], (O)); } while (0)
              f32x4 v = acc[ai][bj][m][n];
              if (MODE == 0) {
                if (tn == 52) {
                  if (ai == 0) *(float4*)((float*)(ws + OFF_DTR) + (size_t)tok * 128 + (nc - 13312)) = make_float4(v[0], v[1], v[2], v[3]);
                } else {
                  u16* dst; int ld, c0;
                  if (tn < 16) { dst = (u16*)(ws + OFF_Z); ld = 4096; c0 = 0; }
                  else if (tn < 40) { dst = (u16*)(ws + OFF_RA); ld = 6144; c0 = 4096; }
                  else if (tn < 48) { dst = (u16*)(ws + OFF_Q); ld = 2048; c0 = 10240; }
                  else if (tn < 50) { dst = (u16*)(ws + OFF_K); ld = 512; c0 = 12288; }
                  else { dst = (u16*)(ws + OFF_V); ld = 512; c0 = 12800; }
                  uint2 o; o.x = pk2(v[0], v[1]); o.y = pk2(v[2], v[3]);
                  WIDE_STORE(dst, ld, c0, o);
                }
              } else if (MODE == 1) {
                uint2 o; o.x = pk2(sigmoidf_(v[0]), sigmoidf_(v[1])); o.y = pk2(sigmoidf_(v[2]), sigmoidf_(v[3]));
                WIDE_STORE((u16*)outp, 4096, 0, o);
              } else if (MODE == 2) {
                const u16* gate = (const u16*)outp;
                uint2 ga = *(const uint2*)(gate + (size_t)tok * 4096 + nc);
                uint2 p1; p1.x = pk2(v[0] * bflo(ga.x), v[1] * bfhi(ga.x)); p1.y = pk2(v[2] * bflo(ga.y), v[3] * bfhi(ga.y));
                *(uint2*)((u16*)(ws + OFF_YB) + (size_t)tok * DM + nc) = p1;
              } else if (MODE == 6) {
                const u16* gate = (const u16*)outp;
                uint2 gb = *(const uint2*)(gate + (size_t)tok * 4096 + 2048 + nc);
                const uint2 p1 = *(const uint2*)((const u16*)(ws + OFF_YB) + (size_t)tok * DM + nc);
                uint2 o;
                o.x = pk2(bflo(p1.x) + v[0] * bflo(gb.x), bfhi(p1.x) + v[1] * bfhi(gb.x));
                o.y = pk2(bflo(p1.y) + v[2] * bflo(gb.y), bfhi(p1.y) + v[3] * bfhi(gb.y));
                WIDE_STORE((u16*)(ws + OFF_RB + 128 * MiB), DM, 0, o);
              } else if (MODE == 3) {
                float4 r = ldnt4(xin + (size_t)tok * DM + nc);
                uint2 hb; hb.x = pk2(r.x + v[0], r.y + v[1]); hb.y = pk2(r.z + v[2], r.w + v[3]);
                WIDE_STORE((u16*)(ws + OFF_RB), DM, 0, hb);
              } else {
                uint2* ph = (uint2*)((u16*)(ws + OFF_RB) + (size_t)tok * DM + nc);
                const uint2 hb = *ph;
                uint2 o; o.x = pk2(bflo(hb.x) + v[0], bfhi(hb.x) + v[1]); o.y = pk2(bflo(hb.y) + v[2], bfhi(hb.y) + v[3]);
                WIDE_STORE((u16*)(ws + OFF_RB), DM, 0, o);
              }
#undef WIDE_STORE
            }
    }
    asm volatile("s_waitcnt vmcnt(0)" ::: "memory");
    if (has_next && wr == 1) __builtin_amdgcn_s_barrier();
  }
  }
}

__device__ __forceinline__ void conv_phase(const Params& P, const int pass, const int wvi) {
  const int S = (pass == 0) ? 2048 : 16384;
  unsigned char* ws = wsp(P);
  const int tid = tidx(wvi);
  const u16* __restrict__ xin = (const u16*)(ws + OFF_RA);
  u16* __restrict__ xo = (u16*)(ws + OFF_RB);
  const float* conv_w = lptr(P.conv_w);
  const float* conv_b = lptr(P.conv_b);
  const float* a_log = lptr(P.a_log);
  const float* dt_bias = lptr(P.dt_bias);
  constexpr int TCH = 32;
  const int nitems = (PT / TCH) * 768;
  for (int idx = blockIdx.x * NTHR + tid; idx < nitems; idx += gridDim.x * NTHR) {
    const int cgp = idx % 768, tch = idx / 768;
    const int c0 = cgp * 8, t0 = tch * TCH;
    const int pos0 = t0 % S;
    float wgt[5][8], bias[8];
#pragma unroll
    for (int j = 0; j < 5; ++j) {
      float4 a = *(const float4*)(conv_w + j * CONVD + c0), b = *(const float4*)(conv_w + j * CONVD + c0 + 4);
      wgt[j][0] = a.x; wgt[j][1] = a.y; wgt[j][2] = a.z; wgt[j][3] = a.w; wgt[j][4] = b.x; wgt[j][5] = b.y; wgt[j][6] = b.z; wgt[j][7] = b.w;
    }
    {
      float4 a = *(const float4*)(conv_b + c0), b = *(const float4*)(conv_b + c0 + 4);
      bias[0] = a.x; bias[1] = a.y; bias[2] = a.z; bias[3] = a.w; bias[4] = b.x; bias[5] = b.y; bias[6] = b.z; bias[7] = b.w;
    }
    const uint4 zz = make_uint4(0, 0, 0, 0);
    uint4 r0 = zz, r1, r2, r3, r4;
    {
      const bool v1 = (pos0 - 2 >= 0), v2 = (pos0 - 1 >= 0);
      const uint4 l1 = *(const uint4*)(xin + (size_t)(v1 ? t0 - 2 : t0) * CONVD + c0);
      const uint4 l2 = *(const uint4*)(xin + (size_t)(v2 ? t0 - 1 : t0) * CONVD + c0);
      r1.x = v1 ? l1.x : 0u; r1.y = v1 ? l1.y : 0u; r1.z = v1 ? l1.z : 0u; r1.w = v1 ? l1.w : 0u;
      r2.x = v2 ? l2.x : 0u; r2.y = v2 ? l2.y : 0u; r2.z = v2 ? l2.z : 0u; r2.w = v2 ? l2.w : 0u;
    }
    r3 = *(const uint4*)(xin + (size_t)(t0) * CONVD + c0);
    r4 = *(const uint4*)(xin + (size_t)(t0 + 1) * CONVD + c0);
#pragma unroll
    for (int tt = 0; tt < TCH; ++tt) {
      r0 = r1; r1 = r2; r2 = r3; r3 = r4;
      const int pp = pos0 + tt + 2;
      {
        const bool v4 = (pp < S);
        const uint4 l4 = *(const uint4*)(xin + (size_t)(v4 ? t0 + tt + 2 : t0) * CONVD + c0);
        r4.x = v4 ? l4.x : 0u; r4.y = v4 ? l4.y : 0u; r4.z = v4 ? l4.z : 0u; r4.w = v4 ? l4.w : 0u;
      }
      float o[8];
#pragma unroll
      for (int e = 0; e < 8; ++e) o[e] = bias[e];
#define CONV_ACC(rv, j) do { \
        o[0] += bflo(rv.x) * wgt[j][0]; o[1] += bfhi(rv.x) * wgt[j][1]; \
        o[2] += bflo(rv.y) * wgt[j][2]; o[3] += bfhi(rv.y) * wgt[j][3]; \
        o[4] += bflo(rv.z) * wgt[j][4]; o[5] += bfhi(rv.z) * wgt[j][5]; \
        o[6] += bflo(rv.w) * wgt[j][6]; o[7] += bfhi(rv.w) * wgt[j][7]; } while (0)
      CONV_ACC(r0, 0); CONV_ACC(r1, 1); CONV_ACC(r2, 2); CONV_ACC(r3, 3); CONV_ACC(r4, 4);
#undef CONV_ACC
      uint4 ov;
      ov.x = pk2(siluf_(o[0]), siluf_(o[1])); ov.y = pk2(siluf_(o[2]), siluf_(o[3]));
      ov.z = pk2(siluf_(o[4]), siluf_(o[5])); ov.w = pk2(siluf_(o[6]), siluf_(o[7]));
      *(uint4*)(xo + (size_t)(t0 + tt) * CONVD + c0) = ov;
    }
  }
  const float* dtr = (const float*)(ws + OFF_DTR);
  float* dtt = (float*)(ws + OFF_DTT);
  float* cum = (float*)(ws + OFF_CUM);
  const int lane = tid & 63, wv = __builtin_amdgcn_readfirstlane(tid >> 6);
  for (int it = blockIdx.x * 8 + wv; it < (PT / 128) * 128; it += gridDim.x * 8) {
    const int dh = it & 127, ch = it >> 7, dir = dh >> 6;
    const int tb = ch * 128;
    const float Ac = -__expf(a_log[dh]);
    const float db = dt_bias[dh];
    const int e0 = dir ? (127 - 2 * lane) : (2 * lane), e1 = dir ? (126 - 2 * lane) : (2 * lane + 1);
    float x0 = dtr[(size_t)(tb + e0) * 128 + dh] + db, x1 = dtr[(size_t)(tb + e1) * 128 + dh] + db;
    float d0 = fmaxf(x0, 0.f) + log1pf(__expf(-fabsf(x0))), d1 = fmaxf(x1, 0.f) + log1pf(__expf(-fabsf(x1)));
    float a0 = d0 * Ac, a1 = d1 * Ac;
    float s = a0 + a1;
#pragma unroll
    for (int o = 1; o < 64; o <<= 1) { float v = shfl_src(s, (lane - o) & 63); if (lane >= o) s += v; }
    dtt[(size_t)dh * PT + tb + e0] = d0; dtt[(size_t)dh * PT + tb + e1] = d1;
    cum[(size_t)dh * PT + tb + e0] = s - a1; cum[(size_t)dh * PT + tb + e1] = s;
    const float tot = shfl_src(s, 63), rs = shfl_src(s, (lane >> 4) * 16 + 15);
    float* wwp = (float*)(ws + OFF_WW);
    float* eep = (float*)(ws + OFF_EE);
    wwp[(size_t)dh * PT + tb + e0] = __expf(tot - (s - a1)) * d0; wwp[(size_t)dh * PT + tb + e1] = __expf(tot - s) * d1;
    eep[(size_t)dh * PT + tb + e0] = __expf(rs - (s - a1)) * d0; eep[(size_t)dh * PT + tb + e1] = __expf(rs - s) * d1;
  }
}

constexpr int LDP = 136, LDX = 72;
constexpr size_t OFF_G = OFF_RA + 128 * MiB;
__device__ __forceinline__ void cb_phase(const Params& P, const int wvi) {
  unsigned char* ws = wsp(P);
  const int tid = tidx(wvi), lane = tid & 63, w = wvi, fr = lane & 15, fq = lane >> 4;
  u16* Cs = (u16*)smem;
  u16* Bs = Cs + 128 * LDP;
  const u16* xc = (const u16*)(ws + OFF_RB);
  u16* G = (u16*)(ws + OFF_G);
  for (int itx = blockIdx.x; itx < (PT / 128) * 8; itx += gridDim.x) {
    const int g = itx & 7, ch = itx >> 3;
    const size_t tb = (size_t)ch * 128;
    __syncthreads();
#pragma unroll
    for (int i = 0; i < 4; ++i) {
      const int q = tid + NTHR * i, row = q >> 4, c16 = q & 15;
      const u16* base = xc + (tb + row) * CONVD;
      *(uint4*)(Cs + row * LDP + c16 * 8) = *(const uint4*)(base + 5120 + g * 128 + c16 * 8);
      *(uint4*)(Bs + row * LDP + c16 * 8) = *(const uint4*)(base + 4096 + g * 128 + c16 * 8);
    }
    __syncthreads();
    bf16x8 cf[4];
#pragma unroll
    for (int kk = 0; kk < 4; ++kk) cf[kk] = *(const bf16x8*)(Cs + (w * 16 + fr) * LDP + kk * 32 + fq * 8);
#pragma unroll
    for (int stile = 0; stile < 8; ++stile) {
      f32x4 ga = f32x4{0.f, 0.f, 0.f, 0.f};
#pragma unroll
      for (int kk = 0; kk < 4; ++kk) {
        bf16x8 bfr = *(const bf16x8*)(Bs + (stile * 16 + fr) * LDP + kk * 32 + fq * 8);
        ga = __builtin_amdgcn_mfma_f32_16x16x32_bf16(bfr, cf[kk], ga, 0, 0, 0);
      }
      uint2 o; o.x = pk2(ga[0], ga[1]); o.y = pk2(ga[2], ga[3]);
      *(uint2*)(G + ((size_t)itx * 128 + w * 16 + fr) * 128 + stile * 16 + fq * 4) = o;
    }
  }
  __syncthreads();
}

__device__ __forceinline__ void ssd_item(const Params& P, const int pass, const int item, const int wvi) {
  unsigned char* ws = wsp_plain(P);
  const int tid = tidx(wvi), lane = tid & 63, w = wvi, fr = lane & 15, fq = lane >> 4;
  const int S = (pass == 0) ? 2048 : 16384, nch = S >> 7;
  const int dir = item & 1, h = (item >> 1) & 63, b = item >> 7, g = h >> 3, dh = dir * 64 + h;
  constexpr int SSD_SET = 128 * LDP * 2 + 128 * LDX * 2 + 64 * LDP * 2 + 4 * 128 * 4;
  const u16* xc = (const u16*)(ws + OFF_RB);
  const u16* G = (const u16*)(ws + OFF_G);
  const float* dtt = (const float*)(ws + ((tid < 128) ? OFF_DTT : (tid < 256) ? OFF_CUM : (tid < 384) ? OFF_WW : OFF_EE)) + (size_t)dh * PT + (tid & 127);
  u16* yout = dir ? (u16*)(ws + OFF_YB) : (u16*)(ws + OFF_RA);
  const int it = (w < 4) ? w : 11 - w;
  const int kk_lo = dir ? (it >> 1) : 0, kk_hi = dir ? 3 : (it >> 1);
  f32x4 st[4];
#pragma unroll
  for (int i = 0; i < 4; ++i) st[i] = f32x4{0.f, 0.f, 0.f, 0.f};

  uint4 rb0, rb1, rb2, rb3, rx0, rx1, rc0, rc1, rc2, rc3, rg0, rg1, rg2, rg3;
  float rdt = 0.f;
  const uint4 z4 = make_uint4(0u, 0u, 0u, 0u);
  rg0 = z4; rg1 = z4; rg2 = z4; rg3 = z4;
#define SSD_LDB(i, RB) do { const int q = tid + NTHR * (i), row = q >> 4, c16 = q & 15; \
      RB = *(const uint4*)(xc + (tb_ + row) * CONVD + 4096 + g * 128 + c16 * 8); } while (0)
#define SSD_LDX(i, RX) do { const int q = tid + NTHR * (i), row = q >> 3, c8 = q & 7; \
      RX = *(const uint4*)(xc + (tb_ + row) * CONVD + h * 64 + c8 * 8); } while (0)
#define SSD_LDC(kk, RC) RC = *(const uint4*)(xc + (tb_ + it * 16 + fr) * CONVD + 5120 + g * 128 + (kk) * 32 + fq * 8)
#define SSD_LDG(kk, RG) do { if ((kk) >= kk_lo && (kk) <= kk_hi) \
      RG = *(const uint4*)(G + (((tb_ >> 7) * 8 + g) * 128 + it * 16 + fr) * 128 + (kk) * 32 + fq * 8); } while (0)
#define SSD_ISSUE(c_) do { \
    const int ch_ = dir ? (nch - 1 - (c_)) : (c_); \
    const size_t tb_ = (size_t)b * S + (size_t)ch_ * 128; \
    SSD_LDB(0, rb0); SSD_LDB(1, rb1); SSD_LDB(2, rb2); SSD_LDB(3, rb3); \
    SSD_LDX(0, rx0); SSD_LDX(1, rx1); \
    SSD_LDC(0, rc0); SSD_LDC(1, rc1); SSD_LDC(2, rc2); SSD_LDC(3, rc3); \
    SSD_LDG(0, rg0); SSD_LDG(1, rg1); SSD_LDG(2, rg2); SSD_LDG(3, rg3); \
    rdt = dtt[tb_]; \
  } while (0)
#define SSD_STB(i, RB) do { const int q = tid + NTHR * (i), row = q >> 4, c16 = q & 15; \
      *(uint4*)(Bs + row * LDP + c16 * 8) = RB; } while (0)
#define SSD_STX(i, RX) do { const int q = tid + NTHR * (i), row = q >> 3, c8 = q & 7; \
      *(uint4*)(Xs + row * LDX + c8 * 8) = RX; } while (0)
  unsigned yp[4][2];
#pragma unroll
  for (int pt = 0; pt < 4; ++pt) { yp[pt][0] = 0u; yp[pt][1] = 0u; }
  if (w >= 4) __builtin_amdgcn_s_setprio(1);
  SSD_ISSUE(0);
  for (int c = 0; c < nch; ++c) {
    u16* Bs = (u16*)(smem + (c & 1) * SSD_SET);
    u16* Xs = Bs + 128 * LDP;
    u16* Sb = Xs + 128 * LDX;
    float* fdt = (float*)(Sb + 64 * LDP);
    float* fcum = fdt + 128;
    float* fww = fcum + 128;
    float* fee = fww + 128;
#pragma unroll
    for (int pt = 0; pt < 4; ++pt) {
      uint2 o; o.x = pk2(st[pt][0], st[pt][1]); o.y = pk2(st[pt][2], st[pt][3]);
      *(uint2*)(Sb + (pt * 16 + fr) * LDP + w * 16 + fq * 4) = o;
    }
    SSD_STB(0, rb0); SSD_STB(1, rb1); SSD_STB(2, rb2); SSD_STB(3, rb3);
    SSD_STX(0, rx0); SSD_STX(1, rx1);
    fdt[tid] = rdt;
    const bf16x8 cf0 = __builtin_bit_cast(bf16x8, rc0), cf1 = __builtin_bit_cast(bf16x8, rc1),
                 cf2 = __builtin_bit_cast(bf16x8, rc2), cf3 = __builtin_bit_cast(bf16x8, rc3);
    const uint4 gq0 = rg0, gq1 = rg1, gq2 = rg2, gq3 = rg3;
    __syncthreads();
    if (c > 0) {
      const int chp = dir ? (nch - c) : (c - 1);
      const size_t tbp = (size_t)b * S + (size_t)chp * 128;
#pragma unroll
      for (int pt = 0; pt < 4; pt += 2) {
        const uint2 ya = make_uint2(yp[pt][0], yp[pt][1]), yb2 = make_uint2(yp[pt + 1][0], yp[pt + 1][1]);
        *(uint4*)(yout + (tbp + it * 16 + fr) * DI + h * 64 + (pt + (fq & 1)) * 16 + (fq & ~1) * 4) = swap_pair(ya, yb2);
      }
    }
    SSD_ISSUE((c + 1 < nch) ? (c + 1) : c);
    const float tot = dir ? fcum[0] : fcum[127];
    const float cum_i = fcum[it * 16 + fr];
    const int ii = it * 16 + fr;
    f32x4 y1[4], y2[4];
#pragma unroll
    for (int i = 0; i < 4; ++i) { y1[i] = f32x4{0.f, 0.f, 0.f, 0.f}; y2[i] = f32x4{0.f, 0.f, 0.f, 0.f}; }
    {
      const float dec = __expf(tot);
#pragma unroll
      for (int pt = 0; pt < 4; ++pt)
#pragma unroll
        for (int j = 0; j < 4; ++j) st[pt][j] *= dec;
    }
#pragma unroll
    for (int kk = 0; kk < 4; ++kk) {
      const int s0 = kk * 32 + fq * 8;
      bf16x8 xf[4];
#pragma unroll
      for (int pt = 0; pt < 4; ++pt) {
        const u16* xa = Xs + (kk * 32 + fq * 8 + (fr >> 2)) * LDX + pt * 16 + (fr & 3) * 4;
        xf[pt] = cat8(ldtr(xa), ldtr(xa + 4 * LDX));
      }
      {
        const u16* ba = Bs + (kk * 32 + fq * 8 + (fr >> 2)) * LDP + w * 16 + (fr & 3) * 4;
        const s16x4 b0 = ldtr(ba), b1 = ldtr(ba + 4 * LDP);
        const float4 wa = *(const float4*)(fww + s0), wb = *(const float4*)(fww + s0 + 4);
        const bf16x8 af = pack8(bf2f((u16)b0[0]) * wa.x, bf2f((u16)b0[1]) * wa.y, bf2f((u16)b0[2]) * wa.z, bf2f((u16)b0[3]) * wa.w,
                                bf2f((u16)b1[0]) * wb.x, bf2f((u16)b1[1]) * wb.y, bf2f((u16)b1[2]) * wb.z, bf2f((u16)b1[3]) * wb.w);
#pragma unroll
        for (int pt = 0; pt < 4; ++pt) st[pt] = __builtin_amdgcn_mfma_f32_16x16x32_bf16(af, xf[pt], st[pt], 0, 0, 0);
      }
      if (kk >= kk_lo && kk <= kk_hi) {
        const uint4 gq = (kk == 0) ? gq0 : (kk == 1) ? gq1 : (kk == 2) ? gq2 : gq3;
        const float gv[8] = {bflo(gq.x), bfhi(gq.x), bflo(gq.y), bfhi(gq.y), bflo(gq.z), bfhi(gq.z), bflo(gq.w), bfhi(gq.w)};
        float mv[8];
        if (kk == (it >> 1)) {
          const float4 ca = *(const float4*)(fcum + s0), cb = *(const float4*)(fcum + s0 + 4);
          const float4 da = *(const float4*)(fdt + s0), db = *(const float4*)(fdt + s0 + 4);
          const float cs[8] = {ca.x, ca.y, ca.z, ca.w, cb.x, cb.y, cb.z, cb.w};
          const float ds[8] = {da.x, da.y, da.z, da.w, db.x, db.y, db.z, db.w};
#pragma unroll
          for (int e = 0; e < 8; ++e) {
            const int ss = s0 + e;
            const bool ok = dir ? (ss >= ii) : (ss <= ii);
            mv[e] = ok ? gv[e] * __expf(cum_i - cs[e]) * ds[e] : 0.f;
          }
        } else {
          const float ai = __expf(cum_i - fcum[dir ? kk * 32 : kk * 32 + 31]);
          const float4 ea = *(const float4*)(fee + s0), eb = *(const float4*)(fee + s0 + 4);
          mv[0] = gv[0] * ai * ea.x; mv[1] = gv[1] * ai * ea.y; mv[2] = gv[2] * ai * ea.z; mv[3] = gv[3] * ai * ea.w;
          mv[4] = gv[4] * ai * eb.x; mv[5] = gv[5] * ai * eb.y; mv[6] = gv[6] * ai * eb.z; mv[7] = gv[7] * ai * eb.w;
        }
        const bf16x8 mf = pack8(mv[0], mv[1], mv[2], mv[3], mv[4], mv[5], mv[6], mv[7]);
#pragma unroll
        for (int pt = 0; pt < 4; ++pt) y1[pt] = __builtin_amdgcn_mfma_f32_16x16x32_bf16(xf[pt], mf, y1[pt], 0, 0, 0);
      }
      {
        const bf16x8 cfk = (kk == 0) ? cf0 : (kk == 1) ? cf1 : (kk == 2) ? cf2 : cf3;
#pragma unroll
        for (int pt = 0; pt < 4; ++pt) {
          const bf16x8 sf = *(const bf16x8*)(Sb + (pt * 16 + fr) * LDP + kk * 32 + fq * 8);
          y2[pt] = __builtin_amdgcn_mfma_f32_16x16x32_bf16(sf, cfk, y2[pt], 0, 0, 0);
        }
      }
    }
    {
      const float ec = __expf(cum_i);
#pragma unroll
      for (int pt = 0; pt < 4; ++pt) {
        yp[pt][0] = pk2(y1[pt][0] + ec * y2[pt][0], y1[pt][1] + ec * y2[pt][1]);
        yp[pt][1] = pk2(y1[pt][2] + ec * y2[pt][2], y1[pt][3] + ec * y2[pt][3]);
      }
    }
  }
  {
    const int chp = dir ? 0 : (nch - 1);
    const size_t tbp = (size_t)b * S + (size_t)chp * 128;
#pragma unroll
    for (int pt = 0; pt < 4; pt += 2) {
      const uint2 ya = make_uint2(yp[pt][0], yp[pt][1]), yb2 = make_uint2(yp[pt + 1][0], yp[pt + 1][1]);
      *(uint4*)(yout + (tbp + it * 16 + fr) * DI + h * 64 + (pt + (fq & 1)) * 16 + (fq & ~1) * 4) = swap_pair(ya, yb2);
    }
  }
  __builtin_amdgcn_s_setprio(0);
  __syncthreads();
}

__device__ __forceinline__ void attn_item(const Params& P, const int pass, const int item, const int wvi) {
  unsigned char* ws = wsp_plain(P);
  const int tid = tidx(wvi), lane = tid & 63, w = wvi, fr = lane & 15, fq = lane >> 4;
  const int S = (pass == 0) ? 2048 : 16384, nbs = S >> 7;
  const int h = item & 15, blk = item >> 4, kvh = h >> 2;
  const int nb = blk % nbs, seqbase = (blk / nbs) * S;
  const int qb = blk * 128;
  constexpr int LDV = 144;
  constexpr int ATT_SET = 128 * LDP * 2 + 128 * LDV * 2;
  float* fb = (float*)(smem + 2 * ATT_SET);
  u16* qbuf = (u16*)(ws + OFF_Q);
  const u16* kbuf = (const u16*)(ws + OFF_K);
  const u16* vbuf = (const u16*)(ws + OFF_V);
  if (tid < 257) fb[tid] = lptr(P.rel_bias)[(int)P.bucket[tid] * 16 + h];
  bf16x8 qf[4];
#pragma unroll
  for (int kk = 0; kk < 4; ++kk) qf[kk] = *(const bf16x8*)(qbuf + (size_t)(qb + w * 16 + fr) * DM + h * 128 + kk * 32 + fq * 8);
  float mrun = lptr(P.attn_sink)[h], lrun = 1.f;
  f32x4 oacc[8];
#pragma unroll
  for (int i = 0; i < 8; ++i) oacc[i] = f32x4{0.f, 0.f, 0.f, 0.f};
  const float scale = 0.08838834764831845f;
  const int qi = w * 16 + fr;
  const int kt_lo = (nb == 0) ? 1 : 0, kt_hi = (nb == nbs - 1) ? 1 : 2;
  uint4 pk0, pk1, pk2_, pk3, pv0, pv1, pv2, pv3;
#define ATT_LD(i, RK, RV) do { const int q = tid + NTHR * (i), row = q >> 4, c16 = q & 15; \
      const size_t tok = (size_t)seqbase + (size_t)(nb - 1 + ktn_) * 128 + row; \
      RK = *(const uint4*)(kbuf + tok * 512 + kvh * 128 + c16 * 8); \
      RV = *(const uint4*)(vbuf + tok * 512 + kvh * 128 + c16 * 8); } while (0)
#define ATT_ISSUE(kt_) do { const int ktn_ = (kt_); ATT_LD(0, pk0, pv0); ATT_LD(1, pk1, pv1); ATT_LD(2, pk2_, pv2); ATT_LD(3, pk3, pv3); } while (0)
#define ATT_ST(i, RK, RV) do { const int q = tid + NTHR * (i), row = q >> 4, c16 = q & 15; \
      *(uint4*)(Ks + row * LDP + c16 * 8) = RK; *(uint4*)(Vs + row * LDV + c16 * 8) = RV; } while (0)
  if (w >= 4) __builtin_amdgcn_s_setprio(1);
  ATT_ISSUE(kt_lo);
  for (int kt = kt_lo; kt <= kt_hi; ++kt) {
    u16* Ks = (u16*)(smem + (kt & 1) * ATT_SET);
    u16* Vs = Ks + 128 * LDP;
    ATT_ST(0, pk0, pv0); ATT_ST(1, pk1, pv1); ATT_ST(2, pk2_, pv2); ATT_ST(3, pk3, pv3);
    __syncthreads();
    ATT_ISSUE((kt < kt_hi) ? kt + 1 : kt);
    f32x4 sc[8];
    float mx = -INFINITY;
#pragma unroll
    for (int t8 = 0; t8 < 8; ++t8) {
      f32x4 a = f32x4{0.f, 0.f, 0.f, 0.f};
#pragma unroll
      for (int kk = 0; kk < 4; ++kk) {
        bf16x8 kf = *(const bf16x8*)(Ks + (t8 * 16 + fr) * LDP + kk * 32 + fq * 8);
        a = __builtin_amdgcn_mfma_f32_16x16x32_bf16(kf, qf[kk], a, 0, 0, 0);
      }
#pragma unroll
      for (int j = 0; j < 4; ++j) {
        const int rel = (kt - 1) * 128 + t8 * 16 + fq * 4 + j - qi;
        const bool ok = (rel >= -128) && (rel <= 128);
        const int ri = ok ? rel + 128 : 0;
        const float v = ok ? (a[j] * scale + fb[ri]) : -INFINITY;
        a[j] = v;
        mx = fmaxf(mx, v);
      }
      sc[t8] = a;
    }
    mx = fmaxf(mx, shfl_src(mx, lane ^ 16));
    mx = fmaxf(mx, shfl_src(mx, lane ^ 32));
    const float mnew = fmaxf(mrun, mx);
    const float alpha = __expf(mrun - mnew);
    float psum = 0.f;
#pragma unroll
    for (int t8 = 0; t8 < 8; ++t8)
#pragma unroll
      for (int j = 0; j < 4; ++j) { const float pv = __expf(sc[t8][j] - mnew); sc[t8][j] = pv; psum += pv; }
    psum += shfl_src(psum, lane ^ 16);
    psum += shfl_src(psum, lane ^ 32);
    lrun = lrun * alpha + psum;
    mrun = mnew;
#pragma unroll
    for (int d8 = 0; d8 < 8; ++d8)
#pragma unroll
      for (int j = 0; j < 4; ++j) oacc[d8][j] *= alpha;
#pragma unroll
    for (int kp = 0; kp < 4; ++kp) {
      const bf16x8 pf = pack8(sc[2 * kp][0], sc[2 * kp][1], sc[2 * kp][2], sc[2 * kp][3],
                              sc[2 * kp + 1][0], sc[2 * kp + 1][1], sc[2 * kp + 1][2], sc[2 * kp + 1][3]);
#pragma unroll
      for (int d8 = 0; d8 < 8; ++d8) {
        const u16* va = Vs + (kp * 32 + fq * 4 + (fr >> 2)) * LDV + d8 * 16 + (fr & 3) * 4;
        s16x4 v0 = ldtr(va), v1 = ldtr(va + 16 * LDV);
        oacc[d8] = __builtin_amdgcn_mfma_f32_16x16x32_bf16(cat8(v0, v1), pf, oacc[d8], 0, 0, 0);
      }
    }
  }
  const float linv = 1.f / lrun;
#pragma unroll
  for (int d8 = 0; d8 < 8; d8 += 2) {
    uint2 oa, ob;
    oa.x = pk2(oacc[d8][0] * linv, oacc[d8][1] * linv); oa.y = pk2(oacc[d8][2] * linv, oacc[d8][3] * linv);
    ob.x = pk2(oacc[d8 + 1][0] * linv, oacc[d8 + 1][1] * linv); ob.y = pk2(oacc[d8 + 1][2] * linv, oacc[d8 + 1][3] * linv);
    *(uint4*)(qbuf + (size_t)(qb + w * 16 + fr) * DM + h * 128 + (d8 + (fq & 1)) * 16 + (fq & ~1) * 4) = swap_pair(oa, ob);
  }
  __builtin_amdgcn_s_setprio(0);
  __syncthreads();
}

__device__ __forceinline__ void mixer_phase(const Params& P, const int pass, const int wvi) {
  __shared__ int s_item;
  int* ctr = (int*)(wsp_plain(P) + OFF_CTL) + pass * 8;
  const int tidm = tidx(wvi);
  const int n_ssd_q = (pass == 0) ? 128 : 16;
  const int n_mix_q = n_ssd_q + 256;
  const int n_gate_q = n_mix_q + 128;
  const int total_q = n_gate_q + 8;
  const int myq = (int)(xb_xcc_id() & 7u);
  for (int qq = 0; qq < 8; ++qq) {
    const int q = (myq + qq) & 7;
    while (true) {
      if (tidm == 0) s_item = atomicAdd(ctr + q, 1);
      __syncthreads();
      const int itx = s_item;
      __syncthreads();
      if (itx >= total_q) break;
      if (itx < n_ssd_q) {
        int b, combo;
        if (pass == 0) { b = q; combo = itx >> 3; } else { b = 0; combo = 2 * q + (itx >> 3); }
        const int g = combo >> 1, dir = combo & 1, h = g * 8 + (itx & 7);
        ssd_item(P, pass, (b << 7) | (h << 1) | dir, wvi);
      } else if (itx < n_mix_q) {
        const int a = itx - n_ssd_q;
        attn_item(P, pass, ((q * 16 + (a >> 4)) << 4) | (a & 15), wvi);
      } else if (itx < n_gate_q) {
        const int gu = itx - n_mix_q;
        const int u = (q * 2 + (gu >> 6)) * 64 + (gu & 63);
        gemm_phase<1>(P, pass, wvi, u, 1 << 20, u + 1);
        __syncthreads();
      } else {
        const int u = 15 * 64 + q * 8 + (itx - n_gate_q);
        gemm_phase<0>(P, pass, wvi, u, 1 << 20, u + 1);
        __syncthreads();
      }
    }
  }
}

__device__ __forceinline__ void combine_phase(const Params& P, const int wvi) {
  unsigned char* ws = wsp(P);
  const int tid = tidx(wvi);
  const int lane = tid & 63, wv = __builtin_amdgcn_readfirstlane(tid >> 6);
  const float* d_skip = lptr(P.d_skip);
  const float* ssm_norm_w = lptr(P.ssm_norm_w);
  u16* yf = (u16*)(ws + OFF_RA);
  const u16* yb = (const u16*)(ws + OFF_YB);
  const u16* xc = (const u16*)(ws + OFF_RB);
  const u16* zb = (const u16*)(ws + OFF_Z);
  const int l16 = lane & 15, sub = lane >> 4;
  const int g = ((blockIdx.x * 8 + wv) * 4 + sub) & 7;
  const int c0 = g * 512 + l16 * 8;
  float4 nw0[4], nw1[4];
  float dsk[4];
#pragma unroll
  for (int j = 0; j < 4; ++j) {
    nw0[j] = *(const float4*)(ssm_norm_w + c0 + j * 128);
    nw1[j] = *(const float4*)(ssm_norm_w + c0 + j * 128 + 4);
    dsk[j] = d_skip[(c0 + j * 128) >> 6];
  }
  for (int it4 = (blockIdx.x * 8 + wv) * 4; it4 < PT * 8; it4 += gridDim.x * 8 * 4) {
    const int it = it4 + sub;
    const int tok = it >> 3;
    uint4 ra[4], rb[4], rx[4], rz[4];
#pragma unroll
    for (int j = 0; j < 4; ++j) {
      const int c = c0 + j * 128;
      ra[j] = ldnt4u(yf + (size_t)tok * DI + c);
      rb[j] = ldnt4u(yb + (size_t)tok * DI + c);
      rx[j] = ldnt4u(xc + (size_t)tok * CONVD + c);
      rz[j] = ldnt4u(zb + (size_t)tok * DI + c);
    }
    float v[4][8];
    float ss = 0.f;
#pragma unroll
    for (int j = 0; j < 4; ++j) {
      const float D = dsk[j];
      const uint4 a = ra[j], b = rb[j], x = rx[j], z = rz[j];
      v[j][0] = (bflo(a.x) + bflo(b.x) + bflo(x.x) * D) * siluf_(bflo(z.x));
      v[j][1] = (bfhi(a.x) + bfhi(b.x) + bfhi(x.x) * D) * siluf_(bfhi(z.x));
      v[j][2] = (bflo(a.y) + bflo(b.y) + bflo(x.y) * D) * siluf_(bflo(z.y));
      v[j][3] = (bfhi(a.y) + bfhi(b.y) + bfhi(x.y) * D) * siluf_(bfhi(z.y));
      v[j][4] = (bflo(a.z) + bflo(b.z) + bflo(x.z) * D) * siluf_(bflo(z.z));
      v[j][5] = (bfhi(a.z) + bfhi(b.z) + bfhi(x.z) * D) * siluf_(bfhi(z.z));
      v[j][6] = (bflo(a.w) + bflo(b.w) + bflo(x.w) * D) * siluf_(bflo(z.w));
      v[j][7] = (bfhi(a.w) + bfhi(b.w) + bfhi(x.w) * D) * siluf_(bfhi(z.w));
#pragma unroll
      for (int e = 0; e < 8; ++e) ss += v[j][e] * v[j][e];
    }
#pragma unroll
    for (int o = 8; o > 0; o >>= 1) ss += shfl_src(ss, lane ^ o);
    const float rstd = rsqrtf(ss * (1.f / 512.f) + EPS);
#pragma unroll
    for (int j = 0; j < 4; ++j) {
      const int c = c0 + j * 128;
      const float4 w0 = nw0[j], w1 = nw1[j];
      uint4 o;
      o.x = pk2(v[j][0] * rstd * w0.x, v[j][1] * rstd * w0.y); o.y = pk2(v[j][2] * rstd * w0.z, v[j][3] * rstd * w0.w);
      o.z = pk2(v[j][4] * rstd * w1.x, v[j][5] * rstd * w1.y); o.w = pk2(v[j][6] * rstd * w1.z, v[j][7] * rstd * w1.w);
      *(uint4*)(yf + (size_t)tok * DI + c) = o;
    }
  }
}

__global__ void __launch_bounds__(NTHR) fwd_megakernel(const Params P) {
  cg::grid_group grid = cg::this_grid();
  __shared__ uint4 xb_words;
  __shared__ int s_vb[4];
  const int wvi = __builtin_amdgcn_readfirstlane((int)(threadIdx.x >> 6));
  if (threadIdx.x == 0) xb_words = make_uint4(0u, 0u, 0u, 0u);
  __syncthreads();
  (void)xcd_barrier_post((unsigned*)(wsp_plain(P) + OFF_CTL + 65536), (volatile LAS unsigned*)&xb_words, wvi);
  if (threadIdx.x == 0) {
    const unsigned x = xb_xcc_id() & 7u;
    s_vb[1] = (int)x;
    s_vb[2] = (int)atomicAdd((unsigned*)(P.ws + OFF_CTL + 8192) + x, 1u);
  }
  phase0(P, wvi);
  if (P.ws == nullptr) grid.sync();
  xcd_barrier(P, (volatile LAS unsigned*)&xb_words, wvi);
  if (threadIdx.x == 0) {
    bool even = (gridDim.x & 7u) == 0u;
    for (int j = 0; j < 8; ++j)
      even = even && (__hip_atomic_load((unsigned*)(P.ws + OFF_CTL + 8192) + j, __ATOMIC_RELAXED, __HIP_MEMORY_SCOPE_AGENT) == gridDim.x / 8u);
    s_vb[0] = even ? (s_vb[1] + 8 * s_vb[2]) : (int)blockIdx.x;
  }
  __syncthreads();
  for (int pass = 0; pass < NPASS; ++pass) {
    rmsnorm_rows<false>(pass_xin(P, pass), P.mix_norm_w, (u16*)(wsp(P) + OFF_XN), nullptr, wvi);
    xcd_barrier(P, (volatile LAS unsigned*)&xb_words, wvi);
    gemm_phase<0>(P, pass, wvi, __builtin_amdgcn_readfirstlane(s_vb[0]), 0, 0, 15);
    xcd_barrier(P, (volatile LAS unsigned*)&xb_words, wvi);
    conv_phase(P, pass, wvi);
    xcd_barrier(P, (volatile LAS unsigned*)&xb_words, wvi);
    cb_phase(P, wvi);
    xcd_barrier(P, (volatile LAS unsigned*)&xb_words, wvi);
    mixer_phase(P, pass, wvi);
    xcd_barrier(P, (volatile LAS unsigned*)&xb_words, wvi);
    combine_phase(P, wvi);
    xcd_barrier(P, (volatile LAS unsigned*)&xb_words, wvi);
    gemm_phase<2>(P, pass, wvi, __builtin_amdgcn_readfirstlane(s_vb[0]));
    gemm_phase<6>(P, pass, wvi, __builtin_amdgcn_readfirstlane(s_vb[0]));
    xcd_barrier(P, (volatile LAS unsigned*)&xb_words, wvi);
    gemm_phase<3>(P, pass, wvi, __builtin_amdgcn_readfirstlane(s_vb[0]));
    xcd_barrier(P, (volatile LAS unsigned*)&xb_words, wvi);
    rmsnorm_rows_bf16<false>((const u16*)(wsp(P) + OFF_RB), P.ffn_norm_w, (u16*)(wsp(P) + OFF_RB + 64 * MiB), nullptr, wvi);
    xcd_barrier(P, (volatile LAS unsigned*)&xb_words, wvi);
    gemm_phase<4>(P, pass, wvi, __builtin_amdgcn_readfirstlane(s_vb[0]));
    xcd_barrier(P, (volatile LAS unsigned*)&xb_words, wvi);
    gemm_phase<5>(P, pass, wvi, __builtin_amdgcn_readfirstlane(s_vb[0]));
    xcd_barrier(P, (volatile LAS unsigned*)&xb_words, wvi);
    rmsnorm_rows_bf16<true>((const u16*)(wsp(P) + OFF_RB), P.final_norm_w, nullptr, pass_out(P, pass), wvi);
  }
}

static void fill_buckets(unsigned char* bk) {
  for (int i = 0; i < 257; ++i) {
    int rel = i - 128;
    int half = 16, max_exact = 8;
    int ret = (rel > 0) ? half : 0;
    int n = rel < 0 ? -rel : rel;
    int nn = n > 1 ? n : 1;
    int large = max_exact + (int)(std::log((double)nn / max_exact) / std::log(128.0 / max_exact) * (half - max_exact));
    if (large > half - 1) large = half - 1;
    bk[i] = (unsigned char)(ret + ((n < max_exact) ? n : large));
  }
}

extern "C" void kernel_launch(void* const* d_in, const int* in_sizes, int n_in, void* d_out, int out_size, void* d_ws,
                              size_t ws_size, hipStream_t stream) {
  static int grid_blocks = 0;
  if (grid_blocks == 0) {
    if (ws_size < WS_NEED) { fprintf(stderr, "kernel_launch: workspace too small: %zu < %zu\n", ws_size, (size_t)WS_NEED); grid_blocks = -1; return; }
    int dev = 0, cus = 0, per_cu = 0;
    hipGetDevice(&dev);
    hipDeviceGetAttribute(&cus, hipDeviceAttributeMultiprocessorCount, dev);
    if (hipFuncSetAttribute((const void*)fwd_megakernel, hipFuncAttributeMaxDynamicSharedMemorySize, LDS_BYTES) != hipSuccess) {
      fprintf(stderr, "kernel_launch: hipFuncSetAttribute failed\n"); grid_blocks = -1; return;
    }
    if (hipOccupancyMaxActiveBlocksPerMultiprocessor(&per_cu, (const void*)fwd_megakernel, NTHR, LDS_BYTES) != hipSuccess || per_cu < 1) {
      fprintf(stderr, "kernel_launch: occupancy query says %d blocks/CU\n", per_cu); per_cu = 1;
    }
    (void)hipGetLastError();
    grid_blocks = cus * 1;
  }
  if (grid_blocks < 0) return;
  Params p{};
  const float** pp = (const float**)&p;
  for (int i = 0; i < 19; ++i) pp[i] = (const float*)d_in[i];
  p.out = (float*)d_out;
  p.ws = (unsigned char*)d_ws;
  fill_buckets(p.bucket);
  if (hipMemsetAsync((unsigned char*)d_ws + OFF_CTL, 0, 131072, stream) != hipSuccess) { fprintf(stderr, "kernel_launch: memset of control words failed\n"); return; }
  void* args[] = {&p};
  hipError_t e = hipLaunchCooperativeKernel((const void*)fwd_megakernel, dim3(grid_blocks), dim3(NTHR), args, LDS_BYTES, stream);
  if (e != hipSuccess) fprintf(stderr, "cooperative launch failed: %s (grid %d)\n", hipGetErrorString(e), grid_blocks);
}
```
